# Optimizing an MI355X kernel written in HIP

```python
import math
import jax
import jax.numpy as jnp
from jax import lax
import numpy as np

D_MODEL = 1024
BATCH = 4
SEQ = 8192
DEPTH = 2

CTX_LEN = 256
GRID_W = 64
EPS = 1e-6

DN_HEADS = 4
DN_HEAD_DIM = 128
DN_WIDTH = DN_HEADS * DN_HEAD_DIM
DN_CHUNK = 64
POOL_WINDOWS = (2, 4, 8, 16)
POOL_GROUPS = len(POOL_WINDOWS)
POOL_WIDTH = D_MODEL // 4
POOL_GROUP_DIM = POOL_WIDTH // POOL_GROUPS
SC_WIDTH = D_MODEL // 4
N_BRANCH = 3
D_FF = ((8 * D_MODEL + 3 * 256 - 1) // (3 * 256)) * 256

OFF_Z = 3 * DN_WIDTH
OFF_A = OFF_Z + DN_WIDTH
OFF_BETA = OFF_A + 2 * DN_HEADS
OFF_POOL = OFF_BETA + 2 * DN_HEADS
OFF_SC = OFF_POOL + POOL_WIDTH
OFF_GATE = OFF_SC + 3 * SC_WIDTH
N_IN = OFF_GATE + N_BRANCH * D_MODEL
IN_SPLITS = (OFF_Z, OFF_A, OFF_BETA, OFF_POOL, OFF_SC, OFF_GATE)

kernel_name = "hybrid_parallel_deltanet_pool_shortconv_dit"


def rmsnorm(x, g):
    xf = x.astype(jnp.float32)
    y = xf * lax.rsqrt(jnp.mean(xf * xf, axis=-1, keepdims=True) + EPS)
    return (y * g.astype(jnp.float32)).astype(x.dtype)


def l2norm(x):
    return x * lax.rsqrt(jnp.sum(x * x, axis=-1, keepdims=True) + EPS)


def conv3(x, w):
    xp = jnp.pad(x, ((0, 0), (1, 1), (0, 0)))
    return xp[:, :-2] * w[0] + xp[:, 1:-1] * w[1] + xp[:, 2:] * w[2]


def decay_gate(p_a, p_b, a_log, dt_bias):
    bn, l, _ = p_a.shape
    a = p_a.astype(jnp.float32).reshape(bn, l, 2, DN_HEADS)
    g = -jnp.exp(a_log.astype(jnp.float32)) * jax.nn.softplus(a + dt_bias.astype(jnp.float32))
    beta = jax.nn.sigmoid(p_b.astype(jnp.float32).reshape(bn, l, 2, DN_HEADS))
    return g, beta


def gated_delta_chunked(q, k, v, g, beta, s0):
    bn, l, h, _ = k.shape
    dv = v.shape[-1]
    n = l // DN_CHUNK

    def chunks(t):
        t = t.reshape(bn, n, DN_CHUNK, h, *t.shape[3:])
        return jnp.moveaxis(t, (1, 3), (0, 2))

    kc, vc, bc = chunks(k), chunks(v), chunks(beta)
    gc = jnp.cumsum(chunks(g), axis=-1)
    idx = jnp.arange(DN_CHUNK)
    incl = idx[:, None] >= idx[None, :]
    strict = idx[:, None] > idx[None, :]
    decay = jnp.exp(jnp.where(incl, gc[..., :, None] - gc[..., None, :], -jnp.inf))
    kb = kc * bc[..., None]
    a = jnp.einsum('nbhid,nbhjd->nbhij', kb, kc) * jnp.where(strict, decay, 0.0)
    eye = jnp.eye(DN_CHUNK, dtype=jnp.float32)
    rhs = jnp.concatenate([vc * bc[..., None], kb * jnp.exp(gc)[..., None]], axis=-1)
    sol = lax.linalg.triangular_solve(eye + a, rhs, left_side=True, lower=True, unit_diagonal=True)
    u, w = sol[..., :dv], sol[..., dv:]
    g_last = gc[..., -1]
    k_state = kc * jnp.exp(g_last[..., None] - gc)[..., None]
    with_output = q is not None
    xs = (u, w, k_state, g_last)
    if with_output:
        qc = chunks(q)
        q_dec = qc * jnp.exp(gc)[..., None]
        a_qk = jnp.einsum('nbhid,nbhjd->nbhij', qc, kc) * decay
        xs = xs + (q_dec, a_qk)

    def step(s, xs_i):
        u_i, w_i, k_i, gl_i = xs_i[:4]
        v_new = u_i - jnp.einsum('bhck,bhkv->bhcv', w_i, s)
        s_next = s * jnp.exp(gl_i)[..., None, None] + jnp.einsum('bhck,bhcv->bhkv', k_i, v_new)
        if with_output:
            qd_i, aqk_i = xs_i[4:]
            o_i = jnp.einsum('bhck,bhkv->bhcv', qd_i, s) + jnp.einsum('bhij,bhjv->bhiv', aqk_i, v_new)
            return s_next, o_i
        return s_next, None

    s_fin, o = lax.scan(step, s0, xs)
    if with_output:
        o = jnp.moveaxis(o, (0, 2), (1, 3)).reshape(bn, l, h, dv)
    return o, s_fin


def dn_bidir(q, k, v, g, beta, s0_f, s0_b):
    rev = lambda t: jnp.flip(t, axis=1)
    o_f, s_f = gated_delta_chunked(q, k, v, g[:, :, 0], beta[:, :, 0], s0_f)
    o_b, s_b = gated_delta_chunked(None if q is None else rev(q), rev(k), rev(v),
                                   rev(g[:, :, 1]), rev(beta[:, :, 1]), s0_b)
    o = None if q is None else o_f + rev(o_b)
    return o, s_f, s_b


def box_mean(x, w, axis):
    l = x.shape[axis]
    lo = w // 2
    hi = w - 1 - lo
    cs = jnp.cumsum(x, axis=axis)
    cs = jnp.concatenate([jnp.zeros_like(lax.slice_in_dim(cs, 0, 1, axis=axis)), cs], axis=axis)
    pos = jnp.arange(l)
    start = jnp.clip(pos - lo, 0, l)
    end = jnp.clip(pos + hi + 1, 0, l)
    total = jnp.take(cs, end, axis=axis) - jnp.take(cs, start, axis=axis)
    shape = [1] * x.ndim
    shape[axis] = l
    return total / (end - start).astype(x.dtype).reshape(shape)


def pool_mixer(u, pool_w, pool_scale, rows):
    bn, l, _ = u.shape
    uf = u.astype(jnp.float32)
    outs = []
    for gi, w in enumerate(POOL_WINDOWS):
        ug = uf[..., gi * POOL_GROUP_DIM:(gi + 1) * POOL_GROUP_DIM]
        if rows is None:
            m = box_mean(ug, w, 1)
        else:
            ug2 = ug.reshape(bn, rows, GRID_W, POOL_GROUP_DIM)
            m = box_mean(box_mean(ug2, w, 1), w, 2).reshape(bn, l, POOL_GROUP_DIM)
        outs.append(m - ug)
    d = jnp.stack(outs, axis=2).astype(u.dtype)
    y = jnp.einsum('blgc,gcd->blgd', d, pool_w).reshape(bn, l, POOL_WIDTH)
    return y * pool_scale


def shortconv_mixer(p, conv_w):
    xin, gate_b, gate_c = jnp.split(p, 3, axis=-1)
    return gate_b * conv3(gate_c * xin, conv_w)


def mixer(h, lp, s0_f, s0_b, rows):
    bn, l, _ = h.shape
    p = h @ lp['w_in']
    p_qkv, p_z, p_a, p_b, p_pool, p_sc, p_gate = jnp.split(p, IN_SPLITS, axis=-1)
    qkv = jax.nn.silu(conv3(p_qkv, lp['dn_conv_w'])).astype(jnp.float32)
    qkv = qkv.reshape(bn, l, 3, DN_HEADS, DN_HEAD_DIM)
    q = l2norm(qkv[:, :, 0]) * (DN_HEAD_DIM ** -0.5)
    k = l2norm(qkv[:, :, 1])
    v = qkv[:, :, 2]
    g, beta = decay_gate(p_a, p_b, lp['dn_a_log'], lp['dn_dt_bias'])
    o, s_f, s_b = dn_bidir(q, k, v, g, beta, s0_f, s0_b)
    z = p_z.astype(jnp.float32).reshape(bn, l, DN_HEADS, DN_HEAD_DIM)
    o = rmsnorm(o, lp['dn_norm_g']) * jax.nn.silu(z)
    y_a = o.reshape(bn, l, DN_WIDTH).astype(h.dtype) @ lp['w_br_a']
    y_b = pool_mixer(p_pool, lp['pool_w'], lp['pool_scale'], rows) @ lp['w_br_b']
    y_c = shortconv_mixer(p_sc, lp['sc_conv_w']) @ lp['w_br_c']
    gates = jax.nn.sigmoid(p_gate.reshape(bn, l, N_BRANCH, D_MODEL))
    y = gates[:, :, 0] * y_a + gates[:, :, 1] * y_b + gates[:, :, 2] * y_c
    return y @ lp['w_o'], s_f, s_b


def context_states(h, lp, s0):
    bn, l, _ = h.shape
    w = lp['w_in']
    kv = jax.nn.silu(conv3(h @ w[:, DN_WIDTH:OFF_Z], lp['dn_conv_w'][:, DN_WIDTH:])).astype(jnp.float32)
    kv = kv.reshape(bn, l, 2, DN_HEADS, DN_HEAD_DIM)
    k = l2norm(kv[:, :, 0])
    v = kv[:, :, 1]
    p_a, p_b = jnp.split(h @ w[:, OFF_A:OFF_POOL], 2, axis=-1)
    g, beta = decay_gate(p_a, p_b, lp['dn_a_log'], lp['dn_dt_bias'])
    _, s_f, s_b = dn_bidir(None, k, v, g, beta, s0, s0)
    return s_f, s_b


def swiglu(h, w_gu, w_down):
    gate, up = jnp.split(h @ w_gu, 2, axis=-1)
    return (jax.nn.silu(gate) * up) @ w_down


def modulate(x, norm_g, shift, scale):
    return rmsnorm(x, norm_g) * (1 + scale) + shift


def setup_inputs(seed: int = 0) -> dict:
    key = jax.random.key(seed)
    ks = jax.random.split(key, 24)
    f32 = jnp.float32
    nrm = lambda k, shape, s: jax.random.normal(k, shape, f32) * s
    L = DEPTH
    dt = jnp.exp(jax.random.uniform(ks[9], (L, 2, DN_HEADS), f32, math.log(1e-3), math.log(1e-1)))
    return {
        'x': nrm(ks[0], (BATCH, SEQ, D_MODEL), 1.0),
        'c': nrm(ks[1], (BATCH, D_MODEL), 1.0),
        'ctx': nrm(ks[2], (BATCH, CTX_LEN, D_MODEL), 1.0),
        'c_ctx': nrm(ks[3], (D_MODEL,), 1.0),
        'w_ada': nrm(ks[4], (L, D_MODEL, 6 * D_MODEL), 0.5 * D_MODEL ** -0.5),
        'b_ada': nrm(ks[5], (L, 6 * D_MODEL), 0.01),
        'norm1_g': 1.0 + nrm(ks[6], (L, D_MODEL), 0.1),
        'norm2_g': 1.0 + nrm(ks[7], (L, D_MODEL), 0.1),
        'w_in': nrm(ks[8], (L, D_MODEL, N_IN), D_MODEL ** -0.5),
        'dn_conv_w': nrm(ks[10], (L, 3, 3 * DN_WIDTH), 3 ** -0.5),
        'dn_a_log': jnp.log(jax.random.uniform(ks[11], (L, 2, DN_HEADS), f32, 1.0, 16.0)),
        'dn_dt_bias': dt + jnp.log(-jnp.expm1(-dt)),
        'dn_norm_g': 1.0 + nrm(ks[12], (L, DN_HEAD_DIM), 0.1),
        'pool_w': nrm(ks[13], (L, POOL_GROUPS, POOL_GROUP_DIM, POOL_GROUP_DIM), POOL_GROUP_DIM ** -0.5),
        'pool_scale': 1.0 + nrm(ks[14], (L, POOL_WIDTH), 0.1),
        'sc_conv_w': nrm(ks[15], (L, 3, SC_WIDTH), 3 ** -0.5),
        'w_br_a': nrm(ks[16], (L, DN_WIDTH, D_MODEL), DN_WIDTH ** -0.5),
        'w_br_b': nrm(ks[17], (L, POOL_WIDTH, D_MODEL), POOL_WIDTH ** -0.5),
        'w_br_c': nrm(ks[18], (L, SC_WIDTH, D_MODEL), SC_WIDTH ** -0.5),
        'w_o': nrm(ks[19], (L, D_MODEL, D_MODEL), D_MODEL ** -0.5),
        'w_gu': nrm(ks[20], (L, D_MODEL, 2 * D_FF), D_MODEL ** -0.5),
        'w_down': nrm(ks[21], (L, D_FF, D_MODEL), D_FF ** -0.5),
        'final_norm_g': 1.0 + nrm(ks[22], (D_MODEL,), 0.1),
    }


def reference(x, c, ctx, c_ctx, w_ada, b_ada, norm1_g, norm2_g, w_in, dn_conv_w, dn_a_log,
              dn_dt_bias, dn_norm_g, pool_w, pool_scale, sc_conv_w, w_br_a, w_br_b, w_br_c,
              w_o, w_gu, w_down, final_norm_g):
    bn = x.shape[0]
    rows = x.shape[1] // GRID_W
    s0 = jnp.zeros((bn, DN_HEADS, DN_HEAD_DIM, DN_HEAD_DIM), jnp.float32)
    for l in range(DEPTH):
        lp = {'w_in': w_in[l], 'dn_conv_w': dn_conv_w[l], 'dn_a_log': dn_a_log[l],
              'dn_dt_bias': dn_dt_bias[l], 'dn_norm_g': dn_norm_g[l], 'pool_w': pool_w[l],
              'pool_scale': pool_scale[l], 'sc_conv_w': sc_conv_w[l], 'w_br_a': w_br_a[l],
              'w_br_b': w_br_b[l], 'w_br_c': w_br_c[l], 'w_o': w_o[l]}
        mod = jax.nn.silu(c) @ w_ada[l] + b_ada[l]
        sh1, sc1, g1, sh2, sc2, g2 = jnp.split(mod[:, None, :], 6, axis=-1)
        mod_c = jax.nn.silu(c_ctx) @ w_ada[l] + b_ada[l]
        sh1c, sc1c, g1c, sh2c, sc2c, g2c = jnp.split(mod_c, 6)
        hc = modulate(ctx, norm1_g[l], sh1c, sc1c)
        if l == DEPTH - 1:
            s_f, s_b = context_states(hc, lp, s0)
        else:
            mix_c, s_f, s_b = mixer(hc, lp, s0, s0, None)
            ctx = ctx + g1c * mix_c
            ctx = ctx + g2c * swiglu(modulate(ctx, norm2_g[l], sh2c, sc2c), w_gu[l], w_down[l])
        h = modulate(x, norm1_g[l], sh1, sc1)
        mix, _, _ = mixer(h, lp, s_f, s_b, rows)
        x = x + g1 * mix
        x = x + g2 * swiglu(modulate(x, norm2_g[l], sh2, sc2), w_gu[l], w_down[l])
    return rmsnorm(x, final_norm_g)
```

```cpp
#include <hip/hip_runtime.h>
#include <hip/hip_cooperative_groups.h>
#include <cstdio>
#include <cstdint>
namespace cg = cooperative_groups;

#define LAS __attribute__((address_space(3)))
typedef unsigned short bf16_t;
typedef short bf16x8 __attribute__((ext_vector_type(8)));
typedef float f32x4 __attribute__((ext_vector_type(4)));
typedef unsigned u32x4 __attribute__((ext_vector_type(4)));
typedef unsigned u32x2 __attribute__((ext_vector_type(2)));

constexpr int DM = 1024, NB = 4, SEQ = 8192, CTXL = 256;
constexpr int ML = NB * SEQ;
constexpr int MC = NB * CTXL;
constexpr int MT = ML + MC;
constexpr int NIN = 6160, DFF = 2816;
constexpr int NCHUNK = MT / 64;
constexpr float EPS = 1e-6f;
constexpr int LDS_BYTES = 147456;

constexpr size_t MiB = 1u << 20;
constexpr size_t WS_MOD = 0;
constexpr size_t WS_AB = 1 * MiB;
constexpr size_t WS_GC = 3 * MiB + 512 * 1024;
constexpr size_t WS_CTX = 5 * MiB;
constexpr size_t WS_WIN1 = 10 * MiB;
constexpr size_t WS_WG = WS_WIN1 + 3328 * 1024 * 2;
constexpr size_t WS_WBR = WS_WG + 3072 * 1024 * 2;
constexpr size_t WS_WO3 = WS_WBR + 3072 * 512 * 2;
constexpr size_t WS_WGU = WS_WO3 + 1024 * 3072 * 2;
constexpr size_t WS_WDN = WS_WGU + 5632 * 1024 * 2;
constexpr size_t WS_H = 48 * MiB;
constexpr size_t WS_BOUT = 114 * MiB;
constexpr size_t WS_PQ = 180 * MiB;
constexpr size_t WS_R = 279 * MiB;
constexpr size_t SZ512 = (size_t)MT * 512 * 2;
constexpr size_t WS_QN = WS_R, WS_KT = WS_R + SZ512, WS_WB = WS_R + 2 * SZ512, WS_UB = WS_R + 4 * SZ512, WS_AQK = WS_R + 6 * SZ512;
constexpr size_t SZAQK = (size_t)NCHUNK * 4 * 64 * 64 * 2;
constexpr size_t WS_END = WS_AQK + 2 * SZAQK;
static_assert(WS_WDN + 1024 * 2816 * 2 <= WS_H, "weights");
static_assert(WS_END <= 512 * MiB, "ws");

struct Params {
    const float *x, *c, *ctx, *c_ctx, *w_ada, *b_ada, *norm1_g, *norm2_g, *w_in, *dn_conv_w, *dn_a_log, *dn_dt_bias, *dn_norm_g,
        *pool_w, *pool_scale, *sc_conv_w, *w_br_a, *w_br_b, *w_br_c, *w_o, *w_gu, *w_down, *final_norm_g;
    float* out; unsigned char* ws;
    int ph_lo, ph_hi;
};

__device__ __forceinline__ unsigned f2bf(float f) { unsigned u = __float_as_uint(f); return (u + 0x7fffu + ((u >> 16) & 1u)) >> 16; }
__device__ __forceinline__ unsigned pk2(float lo, float hi) { return f2bf(lo) | (f2bf(hi) << 16); }
__device__ __forceinline__ float bflo(unsigned w) { return __uint_as_float(w << 16); }
__device__ __forceinline__ float bfhi(unsigned w) { return __uint_as_float(w & 0xffff0000u); }
__device__ __forceinline__ float bf2f(bf16_t h) { return __uint_as_float(((unsigned)h) << 16); }
__device__ __forceinline__ float siluf(float x) { return x / (1.f + __expf(-x)); }
__device__ __forceinline__ float sigmf(float x) { return 1.f / (1.f + __expf(-x)); }
__device__ __forceinline__ void unpack8(const u32x4 v, float* f) {
    f[0] = bflo(v.x); f[1] = bfhi(v.x); f[2] = bflo(v.y); f[3] = bfhi(v.y); f[4] = bflo(v.z); f[5] = bfhi(v.z); f[6] = bflo(v.w); f[7] = bfhi(v.w);
}
__device__ __forceinline__ u32x4 pack8(const float* f) { u32x4 w; w.x = pk2(f[0], f[1]); w.y = pk2(f[2], f[3]); w.z = pk2(f[4], f[5]); w.w = pk2(f[6], f[7]); return w; }
__device__ __forceinline__ int opaque_tid() { int t = threadIdx.x; asm volatile("" : "+v"(t)); return t; }
__device__ __forceinline__ bool seq_first(int t) { return t < ML ? ((t & (SEQ - 1)) == 0) : (((t - ML) & (CTXL - 1)) == 0); }
__device__ __forceinline__ bool seq_last(int t) { return t < ML ? ((t & (SEQ - 1)) == SEQ - 1) : (((t - ML) & (CTXL - 1)) == CTXL - 1); }

namespace pg8 {
constexpr int BM = 256, BK = 64, HALF = 128, HTB = HALF * BK * 2, NXCD = 8, WGM = 8;
__device__ __forceinline__ int lds_byte(int r, int c) { const int st = (r >> 4) * 2 + (c >> 5), rr = r & 15, cc = c & 31, ob = rr * 64 + cc * 2; return st * 1024 + (ob ^ (((ob >> 9) & 1) << 5)); }
__device__ __forceinline__ void stage_rc(int b, int& R, int& C) { const int st = b / 1024, sb = b % 1024, swz = sb ^ (((sb >> 9) & 1) << 5); R = (st >> 1) * 16 + swz / 64; C = (st & 1) * 32 + (swz % 64) / 2; }
__device__ __forceinline__ int perm32(int rho) { const int n = rho >> 4, i = rho & 15; return 8 * (i >> 2) + 4 * n + (i & 3); }

struct Unit { int pm, pn, aoff; };
struct Gemm { const bf16_t* A; const bf16_t* Bt; int lda, K; };

struct StaticOrder {
    int nM, nN, nwg, G, c, a_thresh, a_bytes;
    __device__ void init(int M, int N, int G_, int c_) { nM = M / BM; nN = N / BM; nwg = nM * nN; G = G_; c = c_; a_thresh = 1 << 30; a_bytes = 0; }
    __device__ bool next(int i, Unit& u) const {
        const long L = (long)i * G + c; if (L >= nwg) return false;
        int wgid = (int)L; { const int q = nwg / NXCD, r = nwg % NXCD, xcd = wgid % NXCD, off = wgid / NXCD; wgid = (xcd < r ? xcd * (q + 1) : r * (q + 1) + (xcd - r) * q) + off; }
        const int nig = WGM * nN, gid = wgid / nig, fm = gid * WGM, gsz = (nM - fm) < WGM ? (nM - fm) : WGM;
        u.pm = fm + ((wgid % nig) % gsz); u.pn = (wgid % nig) / gsz; u.aoff = (u.pn >= a_thresh) ? a_bytes : 0; return true;
    }
};

template <class Epi, class Sched>
__device__ __forceinline__ void gemm_phase(LAS unsigned char* lds, const Gemm g, const Sched& S, const Epi& E) {
    const int tid = opaque_tid(), wid = __builtin_amdgcn_readfirstlane(tid >> 6), lane = tid & 63, wr = wid >> 2, wc = wid & 3, fr = lane & 15, fq = lane >> 4;
    const int K = g.K, nt = K / BK, lda = g.lda;
    unsigned voffA[2], voffB[2];
#pragma unroll
    for (int i = 0; i < 2; ++i) { int R, C; stage_rc(tid * 16 + i * 8192, R, C); const int Rb = (R & ~31) + perm32(R & 31);
        voffA[i] = (unsigned)(R * lda + C) * 2u; voffB[i] = (unsigned)(Rb * K + C) * 2u; }
    const size_t kstep = (size_t)(BK * 2);
    const size_t hstepA = (size_t)HALF * lda * 2, hstepB = (size_t)HALF * K * 2;
    const size_t tstepA = 2 * hstepA, tstepB = 2 * hstepB;
    const unsigned ldsw = (unsigned)wid * 1024u;
    const int aoff = lds_byte(wr * 64 + fr, fq * 8), boff = lds_byte(wc * 32 + fr, fq * 8);
#define PG8_SA(b, h) (((b) * 2 + (h)) * HTB)
#define PG8_SB(b, h) ((4 + (b) * 2 + (h)) * HTB)
#define PG8_STAGE(bufoff, gbase, voff) do { _Pragma("unroll") for (int _i = 0; _i < 2; ++_i) \
        __builtin_amdgcn_global_load_lds((const unsigned*)((const char*)(gbase) + (voff)[_i]), (LAS unsigned*)(lds + (bufoff) + ldsw + _i * 8192), 16, 0, 0); } while (0)
#define PG8_LDA(dst, b, h) do { _Pragma("unroll") for (int m = 0; m < 4; ++m) _Pragma("unroll") for (int k = 0; k < 2; ++k) dst[m][k] = *(const LAS bf16x8*)(lds + PG8_SA(b, h) + aoff + m * 2048 + k * 1024); } while (0)
#define PG8_LDB(dst, b, h) do { _Pragma("unroll") for (int n = 0; n < 2; ++n) _Pragma("unroll") for (int k = 0; k < 2; ++k) dst[n][k] = *(const LAS bf16x8*)(lds + PG8_SB(b, h) + boff + n * 2048 + k * 1024); } while (0)
#define PG8_MMA(ai, bj, At, Bt) do { __builtin_amdgcn_s_setprio(1); _Pragma("unroll") for (int m = 0; m < 4; ++m) _Pragma("unroll") for (int n = 0; n < 2; ++n) _Pragma("unroll") for (int k = 0; k < 2; ++k) \
        acc[ai][bj][m][n] = __builtin_amdgcn_mfma_f32_16x16x32_bf16(Bt[n][k], At[m][k], acc[ai][bj][m][n], 0, 0, 0); __builtin_amdgcn_s_setprio(0); } while (0)
#define PG8_WAIT_V(n) asm volatile("s_waitcnt vmcnt(" #n ")" ::: "memory")
#define PG8_WAIT_L(n) asm volatile("s_waitcnt lgkmcnt(" #n ")" ::: "memory")
#define PG8_BAR __builtin_amdgcn_s_barrier()
#define PG8_SCHED __builtin_amdgcn_sched_barrier(0)
    Unit cur, nxt; int ui = 0;
    if (!S.next(0, cur)) return;
    f32x4 acc[2][2][4][2];
#pragma unroll
    for (int a = 0; a < 2; ++a)
#pragma unroll
        for (int b = 0; b < 2; ++b)
#pragma unroll
            for (int m = 0; m < 4; ++m)
#pragma unroll
                for (int n = 0; n < 2; ++n) acc[a][b][m][n] = (f32x4){0.f, 0.f, 0.f, 0.f};
    bf16x8 At[4][2], B0[2][2], B1[2][2];
    const char* cA = (const char*)g.A + (size_t)cur.pm * tstepA + cur.aoff; const char* cB = (const char*)g.Bt + (size_t)cur.pn * tstepB;
    PG8_STAGE(PG8_SB(0, 0), cB, voffB); PG8_STAGE(PG8_SB(0, 1), cB + hstepB, voffB); PG8_STAGE(PG8_SA(0, 0), cA, voffA); PG8_STAGE(PG8_SA(0, 1), cA + hstepA, voffA);
    if (wr == 1) PG8_BAR;
    PG8_WAIT_V(2); PG8_BAR;
    PG8_STAGE(PG8_SB(1, 0), cB + kstep, voffB); PG8_STAGE(PG8_SA(1, 0), cA + kstep, voffA); PG8_STAGE(PG8_SB(1, 1), cB + hstepB + kstep, voffB);
    PG8_WAIT_V(6); PG8_BAR;
    for (;;) {
        const bool has_next = S.next(ui + 1, nxt);
        const char* nA = has_next ? (const char*)g.A + (size_t)nxt.pm * tstepA + nxt.aoff : cA; const char* nB = has_next ? (const char*)g.Bt + (size_t)nxt.pn * tstepB : cB;
        for (int t = 0; t < nt; t += 2) {
            const bool last = (t == nt - 2);
            const char* a1 = cA + (size_t)(t + 1) * kstep;
            const char* a2 = last ? nA : cA + (size_t)(t + 2) * kstep; const char* b2 = last ? nB : cB + (size_t)(t + 2) * kstep;
            const char* a3 = a2 + kstep; const char* b3 = b2 + kstep;
            PG8_LDB(B0, 0, 0); PG8_LDB(B1, 0, 1); PG8_SCHED; PG8_LDA(At, 0, 0); PG8_STAGE(PG8_SA(1, 1), a1 + hstepA, voffA);
            PG8_WAIT_V(8); PG8_WAIT_L(0); PG8_BAR; PG8_MMA(0, 0, At, B0); PG8_MMA(0, 1, At, B1); PG8_BAR; PG8_SCHED;
            PG8_LDA(At, 0, 1); PG8_STAGE(PG8_SB(0, 0), b2, voffB); PG8_STAGE(PG8_SB(0, 1), b2 + hstepB, voffB); PG8_STAGE(PG8_SA(0, 0), a2, voffA);
            PG8_WAIT_V(8); PG8_WAIT_L(0); PG8_BAR; PG8_MMA(1, 0, At, B0); PG8_MMA(1, 1, At, B1); PG8_BAR; PG8_SCHED;
            PG8_LDB(B0, 1, 0); PG8_LDB(B1, 1, 1); PG8_SCHED; PG8_LDA(At, 1, 0); PG8_STAGE(PG8_SA(0, 1), a2 + hstepA, voffA);
            PG8_WAIT_V(8); PG8_WAIT_L(0); PG8_BAR; PG8_MMA(0, 0, At, B0); PG8_MMA(0, 1, At, B1); PG8_BAR; PG8_SCHED;
            PG8_LDA(At, 1, 1); PG8_STAGE(PG8_SB(1, 0), b3, voffB); PG8_STAGE(PG8_SB(1, 1), b3 + hstepB, voffB); PG8_STAGE(PG8_SA(1, 0), a3, voffA);
            PG8_WAIT_V(8); PG8_WAIT_L(0); PG8_BAR; PG8_MMA(1, 0, At, B0); PG8_MMA(1, 1, At, B1); PG8_BAR; PG8_SCHED;
        }
        if (wr == 0) PG8_BAR;
        E(acc, cur, wr, wc, fr, fq);
        if (!has_next) break;
#pragma unroll
        for (int a = 0; a < 2; ++a)
#pragma unroll
            for (int b = 0; b < 2; ++b)
#pragma unroll
                for (int m = 0; m < 4; ++m)
#pragma unroll
                    for (int n = 0; n < 2; ++n) acc[a][b][m][n] = (f32x4){0.f, 0.f, 0.f, 0.f};
        cur = nxt; cA = nA; cB = nB; ++ui;
        if (wr == 1) PG8_BAR;
    }
    PG8_WAIT_V(0);
    PG8_BAR;
#undef PG8_SA
#undef PG8_SB
#undef PG8_STAGE
#undef PG8_LDA
#undef PG8_LDB
#undef PG8_MMA
#undef PG8_WAIT_V
#undef PG8_WAIT_L
#undef PG8_BAR
#undef PG8_SCHED
}

typedef f32x4 Acc[2][2][4][2];

struct EpiP2 {
    bf16_t* pq; bf16_t* prest; float* ab;
    __device__ __forceinline__ void operator()(const Acc& acc, const Unit& u, int wr, int wc, int fr, int fq) const {
        const int row0 = u.pm * BM + wr * 64 + fr, colb = u.pn * BM + wc * 32 + 8 * fq;
#pragma unroll
        for (int ai = 0; ai < 2; ++ai)
#pragma unroll
            for (int m = 0; m < 4; ++m) { const size_t row = (size_t)(row0 + ai * HALF + m * 16);
#pragma unroll
                for (int bj = 0; bj < 2; ++bj) { const int col = colb + bj * HALF; const f32x4 v0 = acc[ai][bj][m][0], v1 = acc[ai][bj][m][1];
                    if (col < 3072) { u32x4 w; w.x = pk2(v0[0], v0[1]); w.y = pk2(v0[2], v0[3]); w.z = pk2(v1[0], v1[1]); w.w = pk2(v1[2], v1[3]);
                        if (col < 1536) *(u32x4*)(pq + row * 1536 + col) = w; else *(u32x4*)(prest + row * 1536 + (col - 1536)) = w; }
                    else if (col < 3088) { float* p = ab + row * 16 + (col - 3072); *(f32x4*)p = v0; *(f32x4*)(p + 4) = v1; } } }
    }
};
struct EpiY {
    bf16_t* O; int ldc;
    __device__ __forceinline__ void operator()(const Acc& acc, const Unit& u, int wr, int wc, int fr, int fq) const {
        const int row0 = u.pm * BM + wr * 64 + fr, colb = u.pn * BM + wc * 32 + 8 * fq;
#pragma unroll
        for (int ai = 0; ai < 2; ++ai)
#pragma unroll
            for (int m = 0; m < 4; ++m) { bf16_t* rowp = O + (size_t)(row0 + ai * HALF + m * 16) * ldc + colb;
#pragma unroll
                for (int bj = 0; bj < 2; ++bj) { const f32x4 v0 = acc[ai][bj][m][0], v1 = acc[ai][bj][m][1];
                    u32x4 w; w.x = pk2(v0[0], v0[1]); w.y = pk2(v0[2], v0[3]); w.z = pk2(v1[0], v1[1]); w.w = pk2(v1[2], v1[3]);
                    *(u32x4*)(rowp + bj * HALF) = w; } }
    }
};
struct EpiG {
    bf16_t* Z;
    __device__ __forceinline__ void operator()(const Acc& acc, const Unit& u, int wr, int wc, int fr, int fq) const {
        const int row0 = u.pm * BM + wr * 64 + fr, colb = u.pn * BM + wc * 32 + 8 * fq;
#pragma unroll
        for (int ai = 0; ai < 2; ++ai)
#pragma unroll
            for (int m = 0; m < 4; ++m) { bf16_t* rowp = Z + (size_t)(row0 + ai * HALF + m * 16) * 3072 + colb;
#pragma unroll
                for (int bj = 0; bj < 2; ++bj) { const f32x4 v0 = acc[ai][bj][m][0], v1 = acc[ai][bj][m][1];
                    const u32x4 y = *(const u32x4*)(rowp + bj * HALF);
                    u32x4 w;
                    w.x = pk2(sigmf(v0[0]) * bflo(y.x), sigmf(v0[1]) * bfhi(y.x)); w.y = pk2(sigmf(v0[2]) * bflo(y.y), sigmf(v0[3]) * bfhi(y.y));
                    w.z = pk2(sigmf(v1[0]) * bflo(y.z), sigmf(v1[1]) * bfhi(y.z)); w.w = pk2(sigmf(v1[2]) * bflo(y.w), sigmf(v1[3]) * bfhi(y.w));
                    *(u32x4*)(rowp + bj * HALF) = w; } }
    }
};
struct EpiRes {
    const float* res_lat; const float* res_ctx; float* out_lat; float* out_ctx; const float* gate;
    __device__ __forceinline__ void operator()(const Acc& acc, const Unit& u, int wr, int wc, int fr, int fq) const {
        const int row0 = u.pm * BM + wr * 64 + fr, colb = u.pn * BM + wc * 32 + 8 * fq;
        const bool lat = (u.pm * BM) < ML;
        const int gr = lat ? ((u.pm * BM) >> 13) : 4;
        const float* src = lat ? res_lat : res_ctx - (size_t)ML * 1024; float* dst = lat ? out_lat : out_ctx - (size_t)ML * 1024;
        f32x4 gv[2][2];
#pragma unroll
        for (int bj = 0; bj < 2; ++bj)
#pragma unroll
            for (int n = 0; n < 2; ++n) gv[bj][n] = *(const f32x4*)(gate + gr * 6144 + colb + bj * HALF + 4 * n);
#pragma unroll
        for (int ai = 0; ai < 2; ++ai)
#pragma unroll
            for (int m = 0; m < 4; ++m) { const size_t ro = (size_t)(row0 + ai * HALF + m * 16) * 1024 + colb;
#pragma unroll
                for (int bj = 0; bj < 2; ++bj)
#pragma unroll
                    for (int n = 0; n < 2; ++n) { const f32x4 r = *(const f32x4*)(src + ro + bj * HALF + 4 * n);
                        *(f32x4*)(dst + ro + bj * HALF + 4 * n) = r + gv[bj][n] * acc[ai][bj][m][n]; } }
    }
};
struct EpiSwi {
    bf16_t* H;
    __device__ __forceinline__ void operator()(const Acc& acc, const Unit& u, int wr, int wc, int fr, int fq) const {
        const int row0 = u.pm * BM + wr * 64 + fr, colb = u.pn * HALF + wc * 32 + 8 * fq;
#pragma unroll
        for (int ai = 0; ai < 2; ++ai)
#pragma unroll
            for (int m = 0; m < 4; ++m) { bf16_t* rowp = H + (size_t)(row0 + ai * HALF + m * 16) * DFF + colb;
                const f32x4 g0 = acc[ai][0][m][0], g1 = acc[ai][0][m][1], u0 = acc[ai][1][m][0], u1 = acc[ai][1][m][1];
                u32x4 w;
                w.x = pk2(siluf(g0[0]) * u0[0], siluf(g0[1]) * u0[1]); w.y = pk2(siluf(g0[2]) * u0[2], siluf(g0[3]) * u0[3]);
                w.z = pk2(siluf(g1[0]) * u1[0], siluf(g1[1]) * u1[1]); w.w = pk2(siluf(g1[2]) * u1[2], siluf(g1[3]) * u1[3]);
                *(u32x4*)rowp = w; }
    }
};
}

__device__ __forceinline__ const float* wsrc(const Params& p, int l, int buf, int n, int k) {
    switch (buf) {
    case 0: { const int c = n < 2048 ? n : (n < 3072 ? n + 16 : (n < 3088 ? n - 1024 : -1)); if (c < 0) return nullptr; return p.w_in + (size_t)l * 1024 * NIN + (size_t)k * NIN + c; }
    case 1: return p.w_in + (size_t)l * 1024 * NIN + (size_t)k * NIN + 3088 + n;
    case 2: { const int br = n >> 10, nn = n & 1023;
        if (br == 0) return p.w_br_a + (size_t)l * 512 * 1024 + (size_t)k * 1024 + nn;
        if (br == 1) return k < 256 ? p.w_br_b + (size_t)l * 256 * 1024 + (size_t)k * 1024 + nn : nullptr;
        return k >= 256 ? p.w_br_c + (size_t)l * 256 * 1024 + (size_t)(k - 256) * 1024 + nn : nullptr; }
    case 3: return p.w_o + (size_t)l * 1024 * 1024 + (size_t)(k & 1023) * 1024 + n;
    case 4: { const int t = n >> 8, w = n & 255; const int c = w < 128 ? t * 128 + w : DFF + t * 128 + (w - 128); return p.w_gu + (size_t)l * 1024 * 2 * DFF + (size_t)k * 2 * DFF + c; }
    default: return p.w_down + (size_t)l * DFF * 1024 + (size_t)k * 1024 + n;
    }
}
__device__ void cvt_phase(const Params& p, unsigned char* ws_, int l, unsigned char* sm) {
    float* tile = (float*)sm;
    const int tid = opaque_tid();
    const int cumt[7] = {0, 832, 1600, 1984, 2752, 4160, 4864};
    const int Ks[6] = {1024, 1024, 512, 3072, 1024, 2816};
    const size_t offs[6] = {WS_WIN1, WS_WG, WS_WBR, WS_WO3, WS_WGU, WS_WDN};
    for (int item = blockIdx.x; item < 4864; item += gridDim.x) {
        int buf = 0;
#pragma unroll
        for (int b = 1; b < 6; ++b) if (item >= cumt[b]) buf = b;
        int K = 1024, base = 0; size_t off = WS_WIN1;
#pragma unroll
        for (int b = 0; b < 6; ++b) if (buf == b) { K = Ks[b]; base = cumt[b]; off = offs[b]; }
        const int it = item - base, kt = it % (K / 64), nt = it / (K / 64), n0 = nt * 64, k0 = kt * 64;
        bf16_t* dst = (bf16_t*)(ws_ + off);
        { const int kk = tid >> 3, ng = tid & 7;
#pragma unroll
          for (int i = 0; i < 8; ++i) { const float* s = wsrc(p, l, buf, n0 + ng * 8 + i, k0 + kk); tile[kk * 65 + ng * 8 + i] = s ? *s : 0.f; } }
        __syncthreads();
        { const int nn = tid >> 3, kg = tid & 7; float f[8];
#pragma unroll
          for (int i = 0; i < 8; ++i) f[i] = tile[(kg * 8 + i) * 65 + nn];
          *(u32x4*)(dst + (size_t)(n0 + nn) * K + k0 + kg * 8) = pack8(f); }
        __syncthreads();
    }
}

__device__ void mod_phase(const Params& p, unsigned char* ws_, unsigned char* sm) {
    float* scv = (float*)sm; float* red = scv + 5120; float* mod = (float*)(ws_ + WS_MOD);
    const int tid = opaque_tid();
    for (int i = tid; i < 5120; i += 512) { const int r = i >> 10, k = i & 1023; const float v = r < 4 ? p.c[r * 1024 + k] : p.c_ctx[k]; scv[i] = siluf(v); }
    __syncthreads();
    for (int item = blockIdx.x; item < 192; item += gridDim.x) {
        const int l = item / 96, cb = item % 96, cn = tid & 63, kg = tid >> 6, n = cb * 64 + cn;
        const float* W = p.w_ada + (size_t)l * 1024 * 6144;
        float a0 = 0, a1 = 0, a2 = 0, a3 = 0, a4 = 0;
        for (int kk = 0; kk < 128; ++kk) { const int k = kg * 128 + kk; const float w = W[(size_t)k * 6144 + n];
            a0 += scv[k] * w; a1 += scv[1024 + k] * w; a2 += scv[2048 + k] * w; a3 += scv[3072 + k] * w; a4 += scv[4096 + k] * w; }
        red[(kg * 5 + 0) * 64 + cn] = a0; red[(kg * 5 + 1) * 64 + cn] = a1; red[(kg * 5 + 2) * 64 + cn] = a2; red[(kg * 5 + 3) * 64 + cn] = a3; red[(kg * 5 + 4) * 64 + cn] = a4;
        __syncthreads();
        if (tid < 320) { const int r = tid >> 6, c2 = tid & 63; float s = 0; for (int q = 0; q < 8; ++q) s += red[(q * 5 + r) * 64 + c2];
            mod[(size_t)(l * 5 + r) * 6144 + cb * 64 + c2] = s + p.b_ada[l * 6144 + cb * 64 + c2]; }
        __syncthreads();
    }
}

__device__ void modulate_phase(const Params& p, unsigned char* ws_, int l, int which, const float* src_lat, const float* src_ctx, int nrows) {
    const int tid = opaque_tid(), wave = tid >> 6, lane = tid & 63;
    const float* mod = (const float*)(ws_ + WS_MOD); bf16_t* hb = (bf16_t*)(ws_ + WS_H);
    const float* g = (which == 1 ? p.norm1_g : p.norm2_g) + l * 1024;
    for (int row = blockIdx.x * 8 + wave; row < nrows; row += gridDim.x * 8) {
        const float* xr; int mr;
        if (row < ML) { xr = src_lat + (size_t)row * 1024; mr = row >> 13; } else { xr = src_ctx + (size_t)(row - ML) * 1024; mr = 4; }
        const float* shift = mod + (size_t)(l * 5 + mr) * 6144 + (which == 1 ? 0 : 3072); const float* scale = shift + 1024;
        f32x4 v[4]; float ss = 0.f;
#pragma unroll
        for (int j = 0; j < 4; ++j) { v[j] = *(const f32x4*)(xr + j * 256 + lane * 4); ss += v[j][0] * v[j][0] + v[j][1] * v[j][1] + v[j][2] * v[j][2] + v[j][3] * v[j][3]; }
#pragma unroll
        for (int o = 32; o >= 1; o >>= 1) ss += __shfl_xor(ss, o);
        const float rstd = rsqrtf(ss * (1.f / 1024.f) + EPS);
#pragma unroll
        for (int j = 0; j < 4; ++j) { const int col = j * 256 + lane * 4;
            const f32x4 gg = *(const f32x4*)(g + col), sc = *(const f32x4*)(scale + col), sh = *(const f32x4*)(shift + col);
            float y[4];
#pragma unroll
            for (int e = 0; e < 4; ++e) y[e] = v[j][e] * rstd * gg[e] * (1.f + sc[e]) + sh[e];
            u32x2 w; w.x = pk2(y[0], y[1]); w.y = pk2(y[2], y[3]);
            *(u32x2*)(hb + (size_t)row * 1024 + col) = w; }
    }
}

__device__ void branch_phase(const Params& p, unsigned char* ws_, int l, int nrows, unsigned char* sm) {
    const int tid = opaque_tid();
    const bf16_t* prest = (const bf16_t*)(ws_ + WS_R); bf16_t* bout = (bf16_t*)(ws_ + WS_BOUT);
    for (int base = blockIdx.x * 4; base < nrows; base += gridDim.x * 4) {
        const int tok = base + (tid >> 7), sub = tid & 127;
        if (sub < 64) {
            const int c = sub * 8; float f[8]; unpack8(*(const u32x4*)(prest + (size_t)tok * 1536 + c), f);
#pragma unroll
            for (int e = 0; e < 8; ++e) f[e] = siluf(f[e]);
            *(u32x4*)(bout + (size_t)tok * 1024 + c) = pack8(f);
        } else if (sub < 96) {
            const int c = (sub - 64) * 8; const bool fst = seq_first(tok), lst = seq_last(tok);
            const bf16_t* r0 = prest + (size_t)tok * 1536;
            float x0[8], b0[8], c0[8], xm[8], cm[8], xp[8], cp[8];
            unpack8(*(const u32x4*)(r0 + 768 + c), x0); unpack8(*(const u32x4*)(r0 + 1024 + c), b0); unpack8(*(const u32x4*)(r0 + 1280 + c), c0);
            if (!fst) { unpack8(*(const u32x4*)(r0 - 1536 + 768 + c), xm); unpack8(*(const u32x4*)(r0 - 1536 + 1280 + c), cm); }
            if (!lst) { unpack8(*(const u32x4*)(r0 + 1536 + 768 + c), xp); unpack8(*(const u32x4*)(r0 + 1536 + 1280 + c), cp); }
            const float* cw = p.sc_conv_w + l * 768; float y[8];
#pragma unroll
            for (int e = 0; e < 8; ++e) { const float am = fst ? 0.f : cm[e] * xm[e], a0 = c0[e] * x0[e], ap = lst ? 0.f : cp[e] * xp[e];
                y[e] = b0[e] * (am * cw[c + e] + a0 * cw[256 + c + e] + ap * cw[512 + c + e]); }
            *(u32x4*)(bout + (size_t)tok * 1024 + 768 + c) = pack8(y);
        }
    }
    float* V = (float*)sm; float* Dm = V + 64 * 65; float* Wp = Dm + 64 * 65;
    const int nitems = (nrows > ML) ? (512 + 16) * 4 : 512 * 4;
    for (int item = blockIdx.x; item < nitems; item += gridDim.x) {
        const int gi = item & 3, rb = item >> 2, w = 2 << gi, lo = w >> 1, hi = w - 1 - lo;
        for (int i = tid; i < 4096; i += 512) Wp[i] = p.pool_w[(size_t)(l * 4 + gi) * 4096 + i];
        const int c = tid >> 3, cg8 = tid & 7, ch0 = cg8 * 8, colb = 512 + gi * 64 + ch0;
        float own[8], acc[8], d[8]; int tokbase;
#pragma unroll
        for (int e = 0; e < 8; ++e) { acc[e] = 0.f; own[e] = 0.f; }
        if (rb < 512) {
            const int b = rb >> 7, r = rb & 127, r0 = max(r - lo, 0), r1 = min(r + hi, 127); tokbase = b * SEQ + r * 64;
            for (int rr = r0; rr <= r1; ++rr) { float f[8]; unpack8(*(const u32x4*)(prest + (size_t)(b * SEQ + rr * 64 + c) * 1536 + colb), f);
#pragma unroll
                for (int e = 0; e < 8; ++e) { acc[e] += f[e]; if (rr == r) own[e] = f[e]; } }
#pragma unroll
            for (int e = 0; e < 8; ++e) V[c * 65 + ch0 + e] = acc[e];
            __syncthreads();
            const int c0 = max(c - lo, 0), c1 = min(c + hi, 63); const float inv = 1.f / (float)((r1 - r0 + 1) * (c1 - c0 + 1));
            float s[8];
#pragma unroll
            for (int e = 0; e < 8; ++e) s[e] = 0.f;
            for (int cc = c0; cc <= c1; ++cc) {
#pragma unroll
                for (int e = 0; e < 8; ++e) s[e] += V[cc * 65 + ch0 + e]; }
#pragma unroll
            for (int e = 0; e < 8; ++e) d[e] = s[e] * inv - own[e];
        } else {
            const int cb = rb - 512, b = cb >> 2, s0 = (cb & 3) * 64 + c, sa = max(s0 - lo, 0), sb = min(s0 + hi, CTXL - 1); tokbase = ML + cb * 64;
            for (int s2 = sa; s2 <= sb; ++s2) { float f[8]; unpack8(*(const u32x4*)(prest + (size_t)(ML + b * CTXL + s2) * 1536 + colb), f);
#pragma unroll
                for (int e = 0; e < 8; ++e) { acc[e] += f[e]; if (s2 == s0) own[e] = f[e]; } }
            const float inv = 1.f / (float)(sb - sa + 1);
#pragma unroll
            for (int e = 0; e < 8; ++e) d[e] = acc[e] * inv - own[e];
            __syncthreads();
        }
#pragma unroll
        for (int e = 0; e < 8; ++e) Dm[c * 65 + ch0 + e] = d[e];
        __syncthreads();
        { const int tok = tid >> 3, dg = tid & 7; float o[8];
#pragma unroll
          for (int e = 0; e < 8; ++e) o[e] = 0.f;
          for (int ch = 0; ch < 64; ++ch) { const float dv = Dm[tok * 65 + ch];
#pragma unroll
              for (int e = 0; e < 8; ++e) o[e] += dv * Wp[ch * 64 + dg * 8 + e]; }
          const float* ps = p.pool_scale + l * 256 + gi * 64 + dg * 8;
#pragma unroll
          for (int e = 0; e < 8; ++e) o[e] *= ps[e];
          *(u32x4*)(bout + (size_t)(tokbase + tok) * 1024 + 512 + gi * 64 + dg * 8) = pack8(o); }
        __syncthreads();
    }
}

template <int D> __device__ __forceinline__ void solve_dir(const float* Am, const float* betaS, const float* gcS, float* Tf, bf16_t* T1, bf16_t* T2, int lane) {
    constexpr int MASK = D ? 63 : 0;
    for (int ip = 0; ip < 64; ++ip) {
        const int i = ip ^ MASK;
        float s = (ip == lane) ? 1.f : 0.f;
#pragma unroll 4
        for (int jp = 0; jp < ip; ++jp) s -= Am[i * 64 + (jp ^ MASK)] * Tf[jp * 64 + lane];
        Tf[ip * 64 + lane] = s;
    }
    const int c = lane ^ MASK; const float bc = betaS[c], ec = bc * __expf(gcS[c]);
    for (int ip = 0; ip < 64; ++ip) { const int i = ip ^ MASK; const float tv = Tf[ip * 64 + lane]; T1[i * 72 + c] = (bf16_t)f2bf(tv * bc); T2[i * 72 + c] = (bf16_t)f2bf(tv * ec); }
}

__device__ void prep_phase(const Params& p, unsigned char* ws_, int l, unsigned char* sm) {
    constexpr int OFF_Q = 0, OFF_K = 17408, OFF_VT = 36864, OFF_KT = 55296, OFF_A = 73728, OFF_G = 106496, OFF_TF = 108544;
    bf16_t* qS = (bf16_t*)(sm + OFF_Q); bf16_t* kS = (bf16_t*)(sm + OFF_K); bf16_t* TS = (bf16_t*)sm;
    bf16_t* vT = (bf16_t*)(sm + OFF_VT); bf16_t* kT = (bf16_t*)(sm + OFF_KT);
    float* Am = (float*)(sm + OFF_A); float* Tf = (float*)(sm + OFF_TF); float* gS = (float*)(sm + OFF_G); float* betaS = gS + 128; float* gcS = gS + 256;
    const int tid = opaque_tid(), wv = tid >> 6, lane = tid & 63, fr = lane & 15, fq = lane >> 4;
    const bf16_t* pq = (const bf16_t*)(ws_ + WS_PQ); const float* ab = (const float*)(ws_ + WS_AB);
    bf16_t* qn = (bf16_t*)(ws_ + WS_QN); bf16_t* kTg = (bf16_t*)(ws_ + WS_KT);
    float* gcg = (float*)(ws_ + WS_GC);
    const float* cw = p.dn_conv_w + (size_t)l * 3 * 1536;
    for (int item = blockIdx.x; item < NCHUNK * 4; item += gridDim.x) {
        const int g = item >> 2, h = item & 3, t0 = g * 64;
        if (tid < 128) { const int d = tid >> 6, i = tid & 63; const float a = ab[(size_t)(t0 + i) * 16 + d * 4 + h], bb = ab[(size_t)(t0 + i) * 16 + 8 + d * 4 + h];
            const float z = a + p.dn_dt_bias[l * 8 + d * 4 + h]; const float sp = fmaxf(z, 0.f) + log1pf(__expf(-fabsf(z)));
            gS[d * 64 + i] = -__expf(p.dn_a_log[l * 8 + d * 4 + h]) * sp; betaS[d * 64 + i] = sigmf(bb); }
        { const int i = tid >> 3, cg8 = tid & 7, t = t0 + i; const bool fst = seq_first(t), lst = seq_last(t);
#pragma unroll
          for (int part = 0; part < 3; ++part) {
              const int col = part * 512 + h * 128 + cg8 * 16; const bf16_t* r0 = pq + (size_t)t * 1536 + col;
              float x0[16], xm[16], xp[16], v[16];
              unpack8(*(const u32x4*)r0, x0); unpack8(*(const u32x4*)(r0 + 8), x0 + 8);
              if (!fst) { unpack8(*(const u32x4*)(r0 - 1536), xm); unpack8(*(const u32x4*)(r0 - 1536 + 8), xm + 8); }
              if (!lst) { unpack8(*(const u32x4*)(r0 + 1536), xp); unpack8(*(const u32x4*)(r0 + 1536 + 8), xp + 8); }
              float ss = 0.f;
#pragma unroll
              for (int e = 0; e < 16; ++e) { const float a = (fst ? 0.f : xm[e]) * cw[col + e] + x0[e] * cw[1536 + col + e] + (lst ? 0.f : xp[e]) * cw[3072 + col + e];
                  v[e] = siluf(a); ss += v[e] * v[e]; }
              if (part < 2) { ss += __shfl_xor(ss, 1); ss += __shfl_xor(ss, 2); ss += __shfl_xor(ss, 4);
                  const float rn = rsqrtf(ss + EPS) * (part == 0 ? 0.08838834764831845f : 1.f);
#pragma unroll
                  for (int e = 0; e < 16; ++e) v[e] *= rn; }
              if (part == 0) { const u32x4 w0 = pack8(v), w1 = pack8(v + 8);
                  *(u32x4*)(qS + i * 136 + cg8 * 16) = w0; *(u32x4*)(qS + i * 136 + cg8 * 16 + 8) = w1;
                  *(u32x4*)(qn + (size_t)t * 512 + h * 128 + cg8 * 16) = w0; *(u32x4*)(qn + (size_t)t * 512 + h * 128 + cg8 * 16 + 8) = w1; }
              else if (part == 1) { *(u32x4*)(kS + i * 136 + cg8 * 16) = pack8(v); *(u32x4*)(kS + i * 136 + cg8 * 16 + 8) = pack8(v + 8);
#pragma unroll
                  for (int e = 0; e < 16; ++e) kT[(cg8 * 16 + e) * 72 + i] = (bf16_t)f2bf(v[e]); }
              else {
#pragma unroll
                  for (int e = 0; e < 16; ++e) vT[(cg8 * 16 + e) * 72 + i] = (bf16_t)f2bf(v[e]); }
          } }
        __syncthreads();
        if (tid == 0) { float s = 0.f; for (int i = 0; i < 64; ++i) { s += gS[i]; gcS[i] = s; } }
        if (tid == 64) { float s = 0.f; for (int i = 63; i >= 0; --i) { s += gS[64 + i]; gcS[64 + i] = s; } }
        { const int j = tid >> 2, part = tid & 3; bf16_t* dst = kTg + ((size_t)(g * 4 + h) * 128 + j) * 64 + part * 16;
          *(u32x4*)dst = *(const u32x4*)(kT + j * 72 + part * 16); *(u32x4*)(dst + 8) = *(const u32x4*)(kT + j * 72 + part * 16 + 8); }
        __syncthreads();
        if (tid < 128) { const int d = tid >> 6, i = tid & 63; gcg[((size_t)d * MT + t0 + i) * 4 + h] = gcS[d * 64 + i]; }
        { const int mt = wv & 3; const bf16_t* XS = (wv < 4) ? qS : kS;
          bf16x8 af[4];
#pragma unroll
          for (int ks = 0; ks < 4; ++ks) af[ks] = *(const bf16x8*)(XS + (mt * 16 + fr) * 136 + ks * 32 + fq * 8);
#pragma unroll
          for (int nt = 0; nt < 4; ++nt) { f32x4 acc = {0.f, 0.f, 0.f, 0.f};
#pragma unroll
              for (int ks = 0; ks < 4; ++ks) { const bf16x8 bfr = *(const bf16x8*)(kS + (nt * 16 + fr) * 136 + ks * 32 + fq * 8);
                  acc = __builtin_amdgcn_mfma_f32_16x16x32_bf16(af[ks], bfr, acc, 0, 0, 0); }
              const int jj = nt * 16 + fr;
#pragma unroll
              for (int j = 0; j < 4; ++j) { const int i = mt * 16 + fq * 4 + j;
#pragma unroll
                  for (int d = 0; d < 2; ++d) { const float e = __expf(fminf(gcS[d * 64 + i] - gcS[d * 64 + jj], 0.f));
                      if (wv < 4) { const bool ok = d == 0 ? (i >= jj) : (i <= jj);
                          ((bf16_t*)(ws_ + WS_AQK + d * SZAQK))[((size_t)(g * 4 + h) * 64 + i) * 64 + jj] = (bf16_t)f2bf(ok ? acc[j] * e : 0.f); }
                      else { const bool ok = d == 0 ? (i > jj) : (i < jj); Am[d * 4096 + i * 64 + jj] = ok ? betaS[d * 64 + i] * acc[j] * e : 0.f; } } } } }
        __syncthreads();
        if (wv == 0) solve_dir<0>(Am, betaS, gcS, Tf, TS, TS + 4608, lane);
        else if (wv == 1) solve_dir<1>(Am + 4096, betaS + 64, gcS + 64, Tf + 4096, TS + 2 * 4608, TS + 3 * 4608, lane);
        __syncthreads();
        { const int d = wv >> 2, which = (wv >> 1) & 1; const bf16_t* Tm = TS + (d * 2 + which) * 4608; const bf16_t* XT = which ? kT : vT;
          bf16_t* dst = (bf16_t*)(ws_ + (which ? WS_WB : WS_UB) + d * SZ512);
#pragma unroll
          for (int mi = 0; mi < 2; ++mi) { const int mt = (wv & 1) * 2 + mi;
              const bf16x8 a0 = *(const bf16x8*)(Tm + (mt * 16 + fr) * 72 + fq * 8), a1 = *(const bf16x8*)(Tm + (mt * 16 + fr) * 72 + 32 + fq * 8);
#pragma unroll
              for (int nt = 0; nt < 8; ++nt) { f32x4 acc = {0.f, 0.f, 0.f, 0.f};
                  acc = __builtin_amdgcn_mfma_f32_16x16x32_bf16(a0, *(const bf16x8*)(XT + (nt * 16 + fr) * 72 + fq * 8), acc, 0, 0, 0);
                  acc = __builtin_amdgcn_mfma_f32_16x16x32_bf16(a1, *(const bf16x8*)(XT + (nt * 16 + fr) * 72 + 32 + fq * 8), acc, 0, 0, 0);
#pragma unroll
                  for (int j = 0; j < 4; ++j) dst[(size_t)(t0 + mt * 16 + fq * 4 + j) * 512 + h * 128 + nt * 16 + fr] = (bf16_t)f2bf(acc[j]); } } }
        __syncthreads();
    }
}

__device__ void scan_phase(const Params& p, unsigned char* ws_, unsigned char* sm) {
    constexpr int ST_W = 0, ST_Q = 17408, ST_KT = 34816, ST_AQK = 53248, ST_U = 62464, ST_GC = 64512, ST_SIZE = 64768;
    constexpr int OFF_ST = 2 * ST_SIZE, OFF_VN = OFF_ST + 4352, OFF_VS = OFF_VN + 2304;
    const int tid = opaque_tid(), wv = tid >> 6, lane = tid & 63, fr = lane & 15, fq = lane >> 4;
    bf16_t* StS = (bf16_t*)(sm + OFF_ST); bf16_t* vnT = (bf16_t*)(sm + OFF_VN); bf16_t* vsT = (bf16_t*)(sm + OFF_VS);
    for (int wu = blockIdx.x; wu < 256; wu += gridDim.x) {
        const int xcd = wu & 7, idx = wu >> 3, chain = xcd * 4 + (idx >> 3), sl = idx & 7, b = chain >> 3, h = (chain >> 1) & 3, d = chain & 1;
        const bf16_t* wb = (const bf16_t*)(ws_ + WS_WB + d * SZ512); const bf16_t* ub = (const bf16_t*)(ws_ + WS_UB + d * SZ512);
        const bf16_t* qn = (const bf16_t*)(ws_ + WS_QN); const bf16_t* kTg = (const bf16_t*)(ws_ + WS_KT);
        const bf16_t* aq = (const bf16_t*)(ws_ + WS_AQK + d * SZAQK); const float* gcg = (const float*)(ws_ + WS_GC) + (size_t)d * MT * 4;
        bf16_t* ob = (bf16_t*)(ws_ + WS_PQ + d * SZ512);
        f32x4 accS = {0.f, 0.f, 0.f, 0.f};
        for (int i = tid; i < 16 * 136; i += 512) StS[i] = 0;
        u32x4 rw0, rw1, rq0, rq1, rk0, rk1, ra, ru; float rg = 0.f;
        ru = (u32x4){0u, 0u, 0u, 0u};
#define SCAN_CHUNK(n) ((n) < 4 ? 512 + b * 4 + (d ? 3 - (n) : (n)) : b * 128 + (d ? 127 - ((n) - 4) : ((n) - 4)))
#define SCAN_LOAD(g) do { const int t0_ = (g) * 64; \
        { const int i_ = tid >> 3, pt_ = tid & 7; const size_t o_ = (size_t)(t0_ + i_) * 512 + h * 128 + pt_ * 16; \
          rw0 = *(const u32x4*)(wb + o_); rw1 = *(const u32x4*)(wb + o_ + 8); rq0 = *(const u32x4*)(qn + o_); rq1 = *(const u32x4*)(qn + o_ + 8); \
          ra = *(const u32x4*)(aq + ((size_t)((g) * 4 + h) * 64 + i_) * 64 + pt_ * 8); } \
        { const int j_ = tid >> 2, pt_ = tid & 3; const size_t o_ = ((size_t)((g) * 4 + h) * 128 + j_) * 64 + pt_ * 16; rk0 = *(const u32x4*)(kTg + o_); rk1 = *(const u32x4*)(kTg + o_ + 8); } \
        if (tid < 128) ru = *(const u32x4*)(ub + (size_t)(t0_ + (tid >> 1)) * 512 + h * 128 + sl * 16 + (tid & 1) * 8); \
        if (tid < 64) rg = gcg[(size_t)(t0_ + tid) * 4 + h]; } while (0)
#define SCAN_STORE(st) do { unsigned char* b_ = sm + (st) * ST_SIZE; \
        { const int i_ = tid >> 3, pt_ = tid & 7; \
          *(u32x4*)(b_ + ST_W + (i_ * 136 + pt_ * 16) * 2) = rw0; *(u32x4*)(b_ + ST_W + (i_ * 136 + pt_ * 16 + 8) * 2) = rw1; \
          *(u32x4*)(b_ + ST_Q + (i_ * 136 + pt_ * 16) * 2) = rq0; *(u32x4*)(b_ + ST_Q + (i_ * 136 + pt_ * 16 + 8) * 2) = rq1; \
          *(u32x4*)(b_ + ST_AQK + (i_ * 72 + pt_ * 8) * 2) = ra; } \
        { const int j_ = tid >> 2, pt_ = tid & 3; *(u32x4*)(b_ + ST_KT + (j_ * 72 + pt_ * 16) * 2) = rk0; *(u32x4*)(b_ + ST_KT + (j_ * 72 + pt_ * 16 + 8) * 2) = rk1; } \
        if (tid < 128) *(u32x4*)(b_ + ST_U + ((tid >> 1) * 16 + (tid & 1) * 8) * 2) = ru; \
        if (tid < 64) *(float*)(b_ + ST_GC + tid * 4) = rg; } while (0)
        { const int g0 = SCAN_CHUNK(0); SCAN_LOAD(g0); SCAN_STORE(0); }
        __syncthreads();
        for (int n = 0; n < 132; ++n) {
            const int g = SCAN_CHUNK(n), t0 = g * 64, st = n & 1;
            if (n + 1 < 132) { const int gn = SCAN_CHUNK(n + 1); SCAN_LOAD(gn); }
            const unsigned char* bs = sm + st * ST_SIZE;
            const bf16_t* wS = (const bf16_t*)(bs + ST_W); const bf16_t* qS = (const bf16_t*)(bs + ST_Q); const bf16_t* kTS = (const bf16_t*)(bs + ST_KT);
            const bf16_t* aS = (const bf16_t*)(bs + ST_AQK); const bf16_t* uS = (const bf16_t*)(bs + ST_U); const float* gcS = (const float*)(bs + ST_GC);
            const float gl = gcS[d ? 0 : 63];
            const int mt = wv & 3;
            f32x4 acc1 = {0.f, 0.f, 0.f, 0.f};
            { const bf16_t* XS = (wv < 4) ? wS : qS;
#pragma unroll
              for (int ks = 0; ks < 4; ++ks) acc1 = __builtin_amdgcn_mfma_f32_16x16x32_bf16(*(const bf16x8*)(XS + (mt * 16 + fr) * 136 + ks * 32 + fq * 8),
                                                                                             *(const bf16x8*)(StS + fr * 136 + ks * 32 + fq * 8), acc1, 0, 0, 0); }
            if (wv < 4) { float vn[4], vs[4];
#pragma unroll
                for (int j = 0; j < 4; ++j) { const int i = mt * 16 + fq * 4 + j; vn[j] = bf2f(uS[i * 16 + fr]) - acc1[j]; vs[j] = vn[j] * __expf(gl - gcS[i]); }
                u32x2 w1, w2; w1.x = pk2(vn[0], vn[1]); w1.y = pk2(vn[2], vn[3]); w2.x = pk2(vs[0], vs[1]); w2.y = pk2(vs[2], vs[3]);
                *(u32x2*)(vnT + fr * 72 + mt * 16 + fq * 4) = w1; *(u32x2*)(vsT + fr * 72 + mt * 16 + fq * 4) = w2; }
            __syncthreads();
            if (wv >= 4) { f32x4 acc3 = {0.f, 0.f, 0.f, 0.f};
#pragma unroll
                for (int ks = 0; ks < 2; ++ks) acc3 = __builtin_amdgcn_mfma_f32_16x16x32_bf16(*(const bf16x8*)(aS + (mt * 16 + fr) * 72 + ks * 32 + fq * 8),
                                                                                               *(const bf16x8*)(vnT + fr * 72 + ks * 32 + fq * 8), acc3, 0, 0, 0);
#pragma unroll
                for (int j = 0; j < 4; ++j) { const int i = mt * 16 + fq * 4 + j; const float o = __expf(gcS[i]) * acc1[j] + acc3[j];
                    ob[(size_t)(t0 + i) * 512 + h * 128 + sl * 16 + fr] = (bf16_t)f2bf(o); } }
            { f32x4 accn = {0.f, 0.f, 0.f, 0.f};
#pragma unroll
              for (int ks = 0; ks < 2; ++ks) accn = __builtin_amdgcn_mfma_f32_16x16x32_bf16(*(const bf16x8*)(kTS + (wv * 16 + fr) * 72 + ks * 32 + fq * 8),
                                                                                             *(const bf16x8*)(vsT + fr * 72 + ks * 32 + fq * 8), accn, 0, 0, 0);
              const float egl = __expf(gl);
#pragma unroll
              for (int j = 0; j < 4; ++j) accS[j] = accS[j] * egl + accn[j];
              u32x2 w; w.x = pk2(accS[0], accS[1]); w.y = pk2(accS[2], accS[3]);
              *(u32x2*)(StS + fr * 136 + wv * 16 + fq * 4) = w; }
            if (n + 1 < 132) SCAN_STORE(st ^ 1);
            __syncthreads();
        }
#undef SCAN_CHUNK
#undef SCAN_LOAD
#undef SCAN_STORE
    }
}

__device__ void ofinal_phase(const Params& p, unsigned char* ws_, int l, int nrows) {
    const int tid = opaque_tid();
    const bf16_t* o0 = (const bf16_t*)(ws_ + WS_PQ); const bf16_t* o1 = (const bf16_t*)(ws_ + WS_PQ + SZ512); bf16_t* bout = (bf16_t*)(ws_ + WS_BOUT);
    const float* g = p.dn_norm_g + l * 128;
    for (int base = blockIdx.x * 8; base < nrows; base += gridDim.x * 8) {
        const int tok = base + (tid >> 6), h = (tid >> 4) & 3, part = tid & 15, col = h * 128 + part * 8;
        float a[8], b[8], z[8];
        unpack8(*(const u32x4*)(o0 + (size_t)tok * 512 + col), a); unpack8(*(const u32x4*)(o1 + (size_t)tok * 512 + col), b);
        unpack8(*(const u32x4*)(bout + (size_t)tok * 1024 + col), z);
        float ss = 0.f;
#pragma unroll
        for (int e = 0; e < 8; ++e) { a[e] += b[e]; ss += a[e] * a[e]; }
        ss += __shfl_xor(ss, 1); ss += __shfl_xor(ss, 2); ss += __shfl_xor(ss, 4); ss += __shfl_xor(ss, 8);
        const float rn = rsqrtf(ss * (1.f / 128.f) + EPS);
#pragma unroll
        for (int e = 0; e < 8; ++e) a[e] = a[e] * rn * g[part * 8 + e] * z[e];
        *(u32x4*)(bout + (size_t)tok * 1024 + col) = pack8(a);
    }
}

__device__ void final_phase(const Params& p, float* out_) {
    const int tid = opaque_tid(), wave = tid >> 6, lane = tid & 63;
    for (int row = blockIdx.x * 8 + wave; row < ML; row += gridDim.x * 8) {
        float* xr = out_ + (size_t)row * 1024;
        f32x4 v[4]; float ss = 0.f;
#pragma unroll
        for (int j = 0; j < 4; ++j) { v[j] = *(const f32x4*)(xr + j * 256 + lane * 4); ss += v[j][0] * v[j][0] + v[j][1] * v[j][1] + v[j][2] * v[j][2] + v[j][3] * v[j][3]; }
#pragma unroll
        for (int o = 32; o >= 1; o >>= 1) ss += __shfl_xor(ss, o);
        const float rstd = rsqrtf(ss * (1.f / 1024.f) + EPS);
#pragma unroll
        for (int j = 0; j < 4; ++j) { const int col = j * 256 + lane * 4; const f32x4 gg = *(const f32x4*)(p.final_norm_g + col);
            f32x4 y; y[0] = v[j][0] * rstd * gg[0]; y[1] = v[j][1] * rstd * gg[1]; y[2] = v[j][2] * rstd * gg[2]; y[3] = v[j][3] * rstd * gg[3];
            *(f32x4*)(xr + col) = y; }
    }
}

#ifndef PH_MASK
#define PH_MASK 0xFFFF
#endif
constexpr int N_PHASES = 26;
__global__ void __launch_bounds__(512, 2) fwd_megakernel(Params pin) {
    extern __shared__ __attribute__((aligned(16))) unsigned char lds[];
    cg::grid_group grid = cg::this_grid();
    LAS unsigned char* ldsl = (LAS unsigned char*)lds;
    const int G = gridDim.x;
    const Params& p0 = pin;
    for (int phi = p0.ph_lo; phi < p0.ph_hi; ++phi) {
        int ph = phi; asm volatile("" : "+s"(ph));
        int bx = blockIdx.x; asm volatile("" : "+s"(bx));
        const Params& p = p0;
        unsigned char* ws_ = p0.ws; asm volatile("" : "+s"(ws_));
        float* out_ = p0.out; asm volatile("" : "+s"(out_));
        float* ctxres = (float*)(ws_ + WS_CTX);
        const float* mod = (const float*)(ws_ + WS_MOD);
        bf16_t* hb = (bf16_t*)(ws_ + WS_H);
        if (ph == 0) { if (PH_MASK & 0x1000) { mod_phase(p, ws_, lds); __syncthreads(); cvt_phase(p, ws_, 0, lds); } }
        else if (ph == 25) { if (PH_MASK & 0x2000) final_phase(p, out_); }
        else {
            const int l = (ph - 1) / 12, sp = (ph - 1) % 12;
            const int Mrows = (l == 0) ? MT : ML;
            const float* xl = (l == 0) ? p.x : out_; const float* xc = (l == 0) ? p.ctx : ctxres;
            switch ((PH_MASK >> sp) & 1 ? sp : 99) {
            case 99: break;
            case 0: if (l == 1) cvt_phase(p, ws_, 1, lds); modulate_phase(p, ws_, l, 1, xl, xc, MT); break;
            case 1: { pg8::Gemm g{hb, (const bf16_t*)(ws_ + WS_WIN1), 1024, 1024}; pg8::StaticOrder S; S.init(MT, 3328, G, bx);
                pg8::EpiP2 E{(bf16_t*)(ws_ + WS_PQ), (bf16_t*)(ws_ + WS_R), (float*)(ws_ + WS_AB)};
                pg8::gemm_phase<pg8::EpiP2, pg8::StaticOrder>(ldsl, g, S, E); break; }
            case 2: branch_phase(p, ws_, l, Mrows, lds); break;
            case 3: prep_phase(p, ws_, l, lds); break;
            case 4: scan_phase(p, ws_, lds); break;
            case 5: ofinal_phase(p, ws_, l, Mrows); break;
            case 6: { pg8::Gemm g{(const bf16_t*)(ws_ + WS_BOUT), (const bf16_t*)(ws_ + WS_WBR), 1024, 512}; pg8::StaticOrder S; S.init(Mrows, 3072, G, bx); S.a_thresh = 4; S.a_bytes = 1024;
                pg8::EpiY E{(bf16_t*)(ws_ + WS_R), 3072};
                pg8::gemm_phase<pg8::EpiY, pg8::StaticOrder>(ldsl, g, S, E); break; }
            case 7: { pg8::Gemm g{hb, (const bf16_t*)(ws_ + WS_WG), 1024, 1024}; pg8::StaticOrder S; S.init(Mrows, 3072, G, bx);
                pg8::EpiG E{(bf16_t*)(ws_ + WS_R)};
                pg8::gemm_phase<pg8::EpiG, pg8::StaticOrder>(ldsl, g, S, E); break; }
            case 8: { pg8::Gemm g{(const bf16_t*)(ws_ + WS_R), (const bf16_t*)(ws_ + WS_WO3), 3072, 3072}; pg8::StaticOrder S; S.init(Mrows, 1024, G, bx);
                pg8::EpiRes E{xl, xc, out_, ctxres, mod + (size_t)l * 5 * 6144 + 2048};
                pg8::gemm_phase<pg8::EpiRes, pg8::StaticOrder>(ldsl, g, S, E); break; }
            case 9: modulate_phase(p, ws_, l, 2, out_, ctxres, Mrows); break;
            case 10: { pg8::Gemm g{hb, (const bf16_t*)(ws_ + WS_WGU), 1024, 1024}; pg8::StaticOrder S; S.init(Mrows, 2 * DFF, G, bx);
                pg8::EpiSwi E{(bf16_t*)(ws_ + WS_R)};
                pg8::gemm_phase<pg8::EpiSwi, pg8::StaticOrder>(ldsl, g, S, E); break; }
            case 11: { pg8::Gemm g{(const bf16_t*)(ws_ + WS_R), (const bf16_t*)(ws_ + WS_WDN), DFF, DFF}; pg8::StaticOrder S; S.init(Mrows, 1024, G, bx);
                pg8::EpiRes E{out_, ctxres, out_, ctxres, mod + (size_t)l * 5 * 6144 + 5120};
                pg8::gemm_phase<pg8::EpiRes, pg8::StaticOrder>(ldsl, g, S, E); break; }
            }
        }
        if (phi + 1 < p0.ph_hi) grid.sync();
    }
}

extern "C" void kernel_launch(void* const* d_in, const int* in_sizes, int n_in, void* d_out, int out_size, void* d_ws, size_t ws_size, hipStream_t stream) {
    static int grid_blocks = 0;
    if (grid_blocks == 0) {
        if (n_in != 23 || out_size != ML * DM || ws_size < WS_END) { fprintf(stderr, "kernel_launch: unexpected shapes (n_in %d out %d ws %zu)\n", n_in, out_size, ws_size); grid_blocks = -1; return; }
        int dev = 0, cus = 0, per_cu = 0;
        hipGetDevice(&dev);
        hipDeviceGetAttribute(&cus, hipDeviceAttributeMultiprocessorCount, dev);
        if (hipFuncSetAttribute((const void*)fwd_megakernel, hipFuncAttributeMaxDynamicSharedMemorySize, LDS_BYTES) != hipSuccess) { fprintf(stderr, "kernel_launch: hipFuncSetAttribute failed\n"); grid_blocks = -1; return; }
        hipOccupancyMaxActiveBlocksPerMultiprocessor(&per_cu, (const void*)fwd_megakernel, 512, LDS_BYTES);
        if (per_cu < 1) { fprintf(stderr, "kernel_launch: occupancy query says %d blocks/CU\n", per_cu); grid_blocks = -1; return; }
        grid_blocks = cus * (per_cu > 1 ? 1 : per_cu);
    }
    if (grid_blocks < 0) return;
    Params p{};
    const float** pp = (const float**)&p;
    for (int i = 0; i < 23; ++i) pp[i] = (const float*)d_in[i];
    p.out = (float*)d_out; p.ws = (unsigned char*)d_ws; p.ph_lo = 0; p.ph_hi = N_PHASES;
    void* args[] = {&p};
    hipError_t e = hipLaunchCooperativeKernel((const void*)fwd_megakernel, dim3(grid_blocks), dim3(512), args, LDS_BYTES, stream);
    if (e != hipSuccess) fprintf(stderr, "cooperative launch failed: %s (grid %d)\n", hipGetErrorString(e), grid_blocks);
}
```

```cpp
#include <hip/hip_runtime.h>
#include <hip/hip_cooperative_groups.h>
#include <cstdio>
#include <cstdint>
namespace cg = cooperative_groups;

#define LAS __attribute__((address_space(3)))
typedef unsigned short bf16_t;
typedef short bf16x8 __attribute__((ext_vector_type(8)));
typedef float f32x4 __attribute__((ext_vector_type(4)));
typedef unsigned u32x4 __attribute__((ext_vector_type(4)));
typedef unsigned u32x2 __attribute__((ext_vector_type(2)));

constexpr int DM = 1024, NB = 4, SEQ = 8192, CTXL = 256;
constexpr int ML = NB * SEQ;
constexpr int MC = NB * CTXL;
constexpr int MT = ML + MC;
constexpr int NIN = 6160, DFF = 2816;
constexpr int NCHUNK = MT / 64;
constexpr float EPS = 1e-6f;
constexpr int LDS_BYTES = 147456;

constexpr size_t MiB = 1u << 20;
constexpr size_t WS_MOD = 0;
constexpr size_t WS_BAR = 512 * 1024;
constexpr size_t WS_AB = 1 * MiB;
constexpr size_t WS_GC = 3 * MiB + 512 * 1024;
constexpr size_t WS_CTX = 5 * MiB;
constexpr size_t WS_WIN1 = 10 * MiB;
constexpr size_t WS_WG = WS_WIN1 + 3328 * 1024 * 2;
constexpr size_t WS_WBR = WS_WG + 3072 * 1024 * 2;
constexpr size_t WS_WO3 = WS_WBR + 3072 * 1024 * 2;
constexpr size_t WS_WGU = WS_WO3 + 1024 * 1024 * 2;
constexpr size_t WS_WDN = WS_WGU + 5632 * 1024 * 2;
constexpr size_t WS_H = 48 * MiB;
constexpr size_t WS_BOUT = 114 * MiB;
constexpr size_t WS_PQ = 180 * MiB;
constexpr size_t WS_R = 279 * MiB;
constexpr size_t SZ512 = (size_t)MT * 512 * 2;
constexpr size_t WS_QN = WS_R, WS_KT = WS_R + SZ512, WS_WB = WS_R + 2 * SZ512, WS_UB = WS_R + 4 * SZ512, WS_AQK = WS_R + 6 * SZ512;
constexpr size_t SZAQK = (size_t)NCHUNK * 4 * 64 * 64 * 2;
constexpr size_t WS_END = WS_AQK + 2 * SZAQK;
static_assert(WS_WDN + 1024 * 2816 * 2 <= WS_H, "weights");
static_assert(WS_END <= 512 * MiB, "ws");

struct Params {
    const float *x, *c, *ctx, *c_ctx, *w_ada, *b_ada, *norm1_g, *norm2_g, *w_in, *dn_conv_w, *dn_a_log, *dn_dt_bias, *dn_norm_g,
        *pool_w, *pool_scale, *sc_conv_w, *w_br_a, *w_br_b, *w_br_c, *w_o, *w_gu, *w_down, *final_norm_g;
    float* out; unsigned char* ws;
    int ph_lo, ph_hi;
};

typedef float f32x2_t __attribute__((ext_vector_type(2)));
typedef __bf16 bf16x2_t __attribute__((ext_vector_type(2)));
__device__ __forceinline__ unsigned pk2(float lo, float hi) { const f32x2_t v = {lo, hi}; const bf16x2_t b = __builtin_convertvector(v, bf16x2_t); return __builtin_bit_cast(unsigned, b); }
__device__ __forceinline__ unsigned f2bf(float f) { return pk2(f, 0.f) & 0xffffu; }
__device__ __forceinline__ float bflo(unsigned w) { return __uint_as_float(w << 16); }
__device__ __forceinline__ float bfhi(unsigned w) { return __uint_as_float(w & 0xffff0000u); }
__device__ __forceinline__ float bf2f(bf16_t h) { return __uint_as_float(((unsigned)h) << 16); }
__device__ __forceinline__ float siluf(float x) { return x * __builtin_amdgcn_rcpf(1.f + __expf(-x)); }
__device__ __forceinline__ float sigmf(float x) { return __builtin_amdgcn_rcpf(1.f + __expf(-x)); }
__device__ __forceinline__ void unpack8(const u32x4 v, float* f) {
    f[0] = bflo(v.x); f[1] = bfhi(v.x); f[2] = bflo(v.y); f[3] = bfhi(v.y); f[4] = bflo(v.z); f[5] = bfhi(v.z); f[6] = bflo(v.w); f[7] = bfhi(v.w);
}
__device__ __forceinline__ u32x4 pack8(const float* f) { u32x4 w; w.x = pk2(f[0], f[1]); w.y = pk2(f[2], f[3]); w.z = pk2(f[4], f[5]); w.w = pk2(f[6], f[7]); return w; }
__device__ __forceinline__ int opaque_tid(int wvs) { int t; asm volatile("v_mbcnt_lo_u32_b32 %0, -1, 0\n\tv_mbcnt_hi_u32_b32 %0, -1, %0" : "=v"(t)); return (wvs << 6) | t; }
__device__ __forceinline__ int bid_() { int b = blockIdx.x; asm volatile("" : "+s"(b)); return b; }
__device__ __forceinline__ int gdim_() { int g = gridDim.x; asm volatile("" : "+s"(g)); return g; }
__device__ __forceinline__ float lane_get(float v, int src_lane) { return __int_as_float(__builtin_amdgcn_ds_bpermute(src_lane << 2, __float_as_int(v))); }
__device__ __forceinline__ bool seq_first(int t) { return t < ML ? ((t & (SEQ - 1)) == 0) : (((t - ML) & (CTXL - 1)) == 0); }
__device__ __forceinline__ bool seq_last(int t) { return t < ML ? ((t & (SEQ - 1)) == SEQ - 1) : (((t - ML) & (CTXL - 1)) == CTXL - 1); }

namespace pg8 {
constexpr int BM = 256, BK = 64, HALF = 128, HTB = HALF * BK * 2, NXCD = 8, WGM = 8;
__device__ __forceinline__ int lds_byte(int r, int c) { const int st = (r >> 4) * 2 + (c >> 5), rr = r & 15, cc = c & 31, ob = rr * 64 + cc * 2; return st * 1024 + (ob ^ (((ob >> 9) & 1) << 5)); }
__device__ __forceinline__ void stage_rc(int b, int& R, int& C) { const int st = b / 1024, sb = b % 1024, swz = sb ^ (((sb >> 9) & 1) << 5); R = (st >> 1) * 16 + swz / 64; C = (st & 1) * 32 + (swz % 64) / 2; }
__device__ __forceinline__ int perm32(int rho) { const int n = rho >> 4, i = rho & 15; return 8 * (i >> 2) + 4 * n + (i & 3); }

struct Unit { int pm, pn, aoff, boff, ks, kind, nt; };
struct Gemm { const bf16_t* A; const bf16_t* Bt; int lda, ldb, K; const bf16_t* A2; const bf16_t* Bt2; int K2; };

struct StaticOrder {
    int nM, nN, nwg, G, c, a_thresh, a_bytes, triple, fused;
    __device__ void init(int M, int N, int G_, int c_) { nM = M / BM; nN = N / BM; nwg = nM * nN; G = G_; c = c_; a_thresh = 1 << 30; a_bytes = 0; triple = 0; fused = 0; }
    __device__ bool next(int i, Unit& u) const {
        const int sub = fused ? i % 6 : (triple ? i % 3 : 0), br = fused ? (sub >> 1) : sub; const long L = (long)(fused ? i / 6 : (triple ? i / 3 : i)) * G + c; if (L >= nwg) return false;
        int wgid = (int)L; { const int q = nwg / NXCD, r = nwg % NXCD, xcd = wgid % NXCD, off = wgid / NXCD; wgid = (xcd < r ? xcd * (q + 1) : r * (q + 1) + (xcd - r) * q) + off; }
        const int nig = WGM * nN, gid = wgid / nig, fm = gid * WGM, gsz = (nM - fm) < WGM ? (nM - fm) : WGM;
        u.pm = fm + ((wgid % nig) % gsz); u.pn = (wgid % nig) / gsz + 4 * br; u.aoff = (u.pn >= a_thresh) ? a_bytes : 0; u.boff = 0; u.ks = 0; u.kind = 0; u.nt = 0;
        if (fused) { u.kind = sub & 1; u.aoff = u.kind ? 0 : (br == 0 ? 0 : (br == 1 ? 1024 : 1536)); u.nt = u.kind ? 16 : (br == 0 ? 8 : 4); }
        return true;
    }
};

template <class Epi, class Sched, bool FUSED = false>
__device__ __forceinline__ void gemm_phase(LAS unsigned char* lds, const Gemm g, const Sched& S, const Epi& E, int wvs_) {
    const int tid = opaque_tid(wvs_), wid = __builtin_amdgcn_readfirstlane(tid >> 6), lane = tid & 63, wr = wid >> 2, wc = wid & 3, fr = lane & 15, fq = lane >> 4;
    const int K = g.K, nt_c = K / BK, lda = g.lda, ldb = g.ldb;
    unsigned voffA[2], voffB[2];
#pragma unroll
    for (int i = 0; i < 2; ++i) { int R, C; stage_rc(tid * 16 + i * 8192, R, C); const int Rb = (R & ~31) + perm32(R & 31);
        voffA[i] = (unsigned)(R * lda + C) * 2u; voffB[i] = (unsigned)(Rb * ldb + C) * 2u; }
    const size_t kstep = (size_t)(BK * 2);
    const size_t hstepA = (size_t)HALF * lda * 2, hstepB = (size_t)HALF * ldb * 2;
    const size_t tstepA = 2 * hstepA, tstepB = 2 * hstepB;
    const unsigned ldsw = (unsigned)wid * 1024u;
    const int aoff = lds_byte(wr * 64 + fr, fq * 8), boff = lds_byte(wc * 32 + fr, fq * 8);
#define PG8_SA(b, h) (((b) * 2 + (h)) * HTB)
#define PG8_SB(b, h) ((4 + (b) * 2 + (h)) * HTB)
#define PG8_STAGE(bufoff, gbase, voff) do { _Pragma("unroll") for (int _i = 0; _i < 2; ++_i) \
        __builtin_amdgcn_global_load_lds((const unsigned*)((const char*)(gbase) + (voff)[_i]), (LAS unsigned*)(lds + (bufoff) + ldsw + _i * 8192), 16, 0, 0); } while (0)
#define PG8_LDA(dst, b, h) do { _Pragma("unroll") for (int m = 0; m < 4; ++m) _Pragma("unroll") for (int k = 0; k < 2; ++k) dst[m][k] = *(const LAS bf16x8*)(lds + PG8_SA(b, h) + aoff + m * 2048 + k * 1024); } while (0)
#define PG8_LDB(dst, b, h) do { _Pragma("unroll") for (int n = 0; n < 2; ++n) _Pragma("unroll") for (int k = 0; k < 2; ++k) dst[n][k] = *(const LAS bf16x8*)(lds + PG8_SB(b, h) + boff + n * 2048 + k * 1024); } while (0)
#define PG8_MMA(ai, bj, At, Bt) do { __builtin_amdgcn_s_setprio(1); _Pragma("unroll") for (int m = 0; m < 4; ++m) _Pragma("unroll") for (int n = 0; n < 2; ++n) _Pragma("unroll") for (int k = 0; k < 2; ++k) \
        acc[ai][bj][m][n] = __builtin_amdgcn_mfma_f32_16x16x32_bf16(Bt[n][k], At[m][k], acc[ai][bj][m][n], 0, 0, 0); __builtin_amdgcn_s_setprio(0); } while (0)
#define PG8_WAIT_V(n) asm volatile("s_waitcnt vmcnt(" #n ")" ::: "memory")
#define PG8_WAIT_L(n) asm volatile("s_waitcnt lgkmcnt(" #n ")" ::: "memory")
#define PG8_BAR __builtin_amdgcn_s_barrier()
#define PG8_SCHED __builtin_amdgcn_sched_barrier(0)
    Unit cur, nxt; int ui = 0;
    if (!S.next(0, cur)) return;
    f32x4 acc[2][2][4][2];
#pragma unroll
    for (int a = 0; a < 2; ++a)
#pragma unroll
        for (int b = 0; b < 2; ++b)
#pragma unroll
            for (int m = 0; m < 4; ++m)
#pragma unroll
                for (int n = 0; n < 2; ++n) acc[a][b][m][n] = (f32x4){0.f, 0.f, 0.f, 0.f};
    bf16x8 At[4][2], B0[2][2], B1[2][2];
    const char* cA = (const char*)((FUSED && cur.kind) ? g.A2 : g.A) + (size_t)cur.pm * tstepA + cur.aoff; const char* cB = (const char*)((FUSED && cur.kind) ? g.Bt2 : g.Bt) + (size_t)cur.pn * tstepB + cur.boff;
    PG8_STAGE(PG8_SB(0, 0), cB, voffB); PG8_STAGE(PG8_SB(0, 1), cB + hstepB, voffB); PG8_STAGE(PG8_SA(0, 0), cA, voffA); PG8_STAGE(PG8_SA(0, 1), cA + hstepA, voffA);
    if (wr == 1) PG8_BAR;
    PG8_WAIT_V(2); PG8_BAR;
    PG8_STAGE(PG8_SB(1, 0), cB + kstep, voffB); PG8_STAGE(PG8_SA(1, 0), cA + kstep, voffA); PG8_STAGE(PG8_SB(1, 1), cB + hstepB + kstep, voffB);
    PG8_WAIT_V(6); PG8_BAR;
    for (;;) {
        const bool has_next = S.next(ui + 1, nxt);
        const char* nA = has_next ? (const char*)((FUSED && nxt.kind) ? g.A2 : g.A) + (size_t)nxt.pm * tstepA + nxt.aoff : cA; const char* nB = has_next ? (const char*)((FUSED && nxt.kind) ? g.Bt2 : g.Bt) + (size_t)nxt.pn * tstepB + nxt.boff : cB;
        const int nt = FUSED ? cur.nt : nt_c;
        for (int t = 0; t < nt; t += 2) {
            const bool last = (t == nt - 2);
            const char* a1 = cA + (size_t)(t + 1) * kstep;
            const char* a2 = last ? nA : cA + (size_t)(t + 2) * kstep; const char* b2 = last ? nB : cB + (size_t)(t + 2) * kstep;
            const char* a3 = a2 + kstep; const char* b3 = b2 + kstep;
            PG8_LDB(B0, 0, 0); PG8_LDB(B1, 0, 1); PG8_SCHED; PG8_LDA(At, 0, 0); PG8_STAGE(PG8_SA(1, 1), a1 + hstepA, voffA);
            PG8_WAIT_V(8); PG8_WAIT_L(0); PG8_BAR; PG8_MMA(0, 0, At, B0); PG8_MMA(0, 1, At, B1); PG8_BAR; PG8_SCHED;
            PG8_LDA(At, 0, 1); PG8_STAGE(PG8_SB(0, 0), b2, voffB); PG8_STAGE(PG8_SB(0, 1), b2 + hstepB, voffB); PG8_STAGE(PG8_SA(0, 0), a2, voffA);
            PG8_WAIT_V(8); PG8_WAIT_L(0); PG8_BAR; PG8_MMA(1, 0, At, B0); PG8_MMA(1, 1, At, B1); PG8_BAR; PG8_SCHED;
            PG8_LDB(B0, 1, 0); PG8_LDB(B1, 1, 1); PG8_SCHED; PG8_LDA(At, 1, 0); PG8_STAGE(PG8_SA(0, 1), a2 + hstepA, voffA);
            PG8_WAIT_V(8); PG8_WAIT_L(0); PG8_BAR; PG8_MMA(0, 0, At, B0); PG8_MMA(0, 1, At, B1); PG8_BAR; PG8_SCHED;
            PG8_LDA(At, 1, 1); PG8_STAGE(PG8_SB(1, 0), b3, voffB); PG8_STAGE(PG8_SB(1, 1), b3 + hstepB, voffB); PG8_STAGE(PG8_SA(1, 0), a3, voffA);
            PG8_WAIT_V(8); PG8_WAIT_L(0); PG8_BAR; PG8_MMA(1, 0, At, B0); PG8_MMA(1, 1, At, B1); PG8_BAR; PG8_SCHED;
        }
        if (wr == 0) PG8_BAR;
        { const int ln2 = opaque_tid(wvs_) & 63; const int fr2 = ln2 & 15, fq2 = ln2 >> 4;
          E(acc, cur, wr, wc, fr2, fq2); }
        if (!has_next) break;
#pragma unroll
        for (int a = 0; a < 2; ++a)
#pragma unroll
            for (int b = 0; b < 2; ++b)
#pragma unroll
                for (int m = 0; m < 4; ++m)
#pragma unroll
                    for (int n = 0; n < 2; ++n) acc[a][b][m][n] = (f32x4){0.f, 0.f, 0.f, 0.f};
        cur = nxt; cA = nA; cB = nB; ++ui;
        if (wr == 1) PG8_BAR;
    }
    PG8_WAIT_V(0);
    PG8_BAR;
#undef PG8_SA
#undef PG8_SB
#undef PG8_STAGE
#undef PG8_LDA
#undef PG8_LDB
#undef PG8_MMA
#undef PG8_WAIT_V
#undef PG8_WAIT_L
#undef PG8_BAR
#undef PG8_SCHED
}

typedef f32x4 Acc[2][2][4][2];

struct EpiP2 {
    bf16_t* pq; bf16_t* prest; float* ab; bf16_t* bout;
    __device__ __forceinline__ void operator()(const Acc& acc, const Unit& u, int wr, int wc, int fr, int fq) const {
        const int row0 = u.pm * BM + wr * 64 + fr, colb = u.pn * BM + wc * 32 + 8 * fq;
        if (u.pn == 9 || u.pn == 10) {
            const int cx = 256 + (u.pn - 9) * 128 + wc * 32 + 8 * fq;
#pragma unroll
            for (int ai = 0; ai < 2; ++ai)
#pragma unroll
                for (int m = 0; m < 4; ++m) { const f32x4 p0 = acc[ai][0][m][0] * acc[ai][1][m][0], p1 = acc[ai][0][m][1] * acc[ai][1][m][1];
                    u32x4 w; w.x = pk2(p0[0], p0[1]); w.y = pk2(p0[2], p0[3]); w.z = pk2(p1[0], p1[1]); w.w = pk2(p1[2], p1[3]);
                    *(u32x4*)(prest + (size_t)(row0 + ai * HALF + m * 16) * 768 + cx) = w; }
            return; }
#pragma unroll
        for (int ai = 0; ai < 2; ++ai)
#pragma unroll
            for (int m = 0; m < 4; ++m) { const size_t row = (size_t)(row0 + ai * HALF + m * 16);
#pragma unroll
                for (int bj = 0; bj < 2; ++bj) { const int col = colb + bj * HALF; const f32x4 v0 = acc[ai][bj][m][0], v1 = acc[ai][bj][m][1];
                    if (col >= 1536 && col < 2048) { u32x4 w; w.x = pk2(siluf(v0[0]), siluf(v0[1])); w.y = pk2(siluf(v0[2]), siluf(v0[3])); w.z = pk2(siluf(v1[0]), siluf(v1[1])); w.w = pk2(siluf(v1[2]), siluf(v1[3]));
                        *(u32x4*)(bout + row * 1024 + (col - 1536)) = w; }
                    else if (col < 3072) { u32x4 w; w.x = pk2(v0[0], v0[1]); w.y = pk2(v0[2], v0[3]); w.z = pk2(v1[0], v1[1]); w.w = pk2(v1[2], v1[3]);
                        if (col < 1536) *(u32x4*)(pq + row * 1536 + col) = w; else *(u32x4*)(prest + row * 768 + (col < 2304 ? col - 2048 : col - 2304)) = w; }
                    else if (col < 3088) { float* p = ab + row * 16 + (col - 3072); *(f32x4*)p = v0; *(f32x4*)(p + 4) = v1; } } }
    }
};
struct EpiY {
    bf16_t* O; int ldc;
    __device__ __forceinline__ void operator()(const Acc& acc, const Unit& u, int wr, int wc, int fr, int fq) const {
        const int row0 = u.pm * BM + wr * 64 + fr, colb = u.pn * BM + wc * 32 + 8 * fq;
#pragma unroll
        for (int ai = 0; ai < 2; ++ai)
#pragma unroll
            for (int m = 0; m < 4; ++m) { bf16_t* rowp = O + (size_t)(row0 + ai * HALF + m * 16) * ldc + colb;
#pragma unroll
                for (int bj = 0; bj < 2; ++bj) { const f32x4 v0 = acc[ai][bj][m][0], v1 = acc[ai][bj][m][1];
                    u32x4 w; w.x = pk2(v0[0], v0[1]); w.y = pk2(v0[2], v0[3]); w.z = pk2(v1[0], v1[1]); w.w = pk2(v1[2], v1[3]);
                    *(u32x4*)(rowp + bj * HALF) = w; } }
    }
};
struct EpiG {
    const bf16_t* Y; bf16_t* O;
    __device__ __forceinline__ void operator()(const Acc& acc, const Unit& u, int wr, int wc, int fr, int fq) const {
        const int row0 = u.pm * BM + wr * 64 + fr, colb = u.pn * BM + wc * 32 + 8 * fq, br = u.pn >> 2, colo = colb - br * 1024;
#pragma unroll
        for (int ai = 0; ai < 2; ++ai)
#pragma unroll
            for (int m = 0; m < 4; ++m) { const size_t row = (size_t)(row0 + ai * HALF + m * 16);
#pragma unroll
                for (int bj = 0; bj < 2; ++bj) { const f32x4 v0 = acc[ai][bj][m][0], v1 = acc[ai][bj][m][1];
                    const u32x4 y = *(const u32x4*)(Y + row * 3072 + colb + bj * HALF);
                    float f[8];
                    f[0] = sigmf(v0[0]) * bflo(y.x); f[1] = sigmf(v0[1]) * bfhi(y.x); f[2] = sigmf(v0[2]) * bflo(y.y); f[3] = sigmf(v0[3]) * bfhi(y.y);
                    f[4] = sigmf(v1[0]) * bflo(y.z); f[5] = sigmf(v1[1]) * bfhi(y.z); f[6] = sigmf(v1[2]) * bflo(y.w); f[7] = sigmf(v1[3]) * bfhi(y.w);
                    bf16_t* op = O + row * 1024 + colo + bj * HALF;
                    if (br > 0) { float o[8]; unpack8(*(const u32x4*)op, o);
#pragma unroll
                        for (int e = 0; e < 8; ++e) f[e] += o[e]; }
                    *(u32x4*)op = pack8(f); } }
    }
};
struct EpiYG {
    bf16_t* ring; bf16_t* ring2; bf16_t* O;
    __device__ __forceinline__ void operator()(const Acc& acc, const Unit& u, int wr, int wc, int fr, int fq) const {
        const int rl = wr * 64 + fr, cl = wc * 32 + 8 * fq;
        if (u.kind == 0) {
#pragma unroll
            for (int ai = 0; ai < 2; ++ai)
#pragma unroll
                for (int m = 0; m < 4; ++m)
#pragma unroll
                    for (int bj = 0; bj < 2; ++bj) { const f32x4 v0 = acc[ai][bj][m][0], v1 = acc[ai][bj][m][1];
                        u32x4 w; w.x = pk2(v0[0], v0[1]); w.y = pk2(v0[2], v0[3]); w.z = pk2(v1[0], v1[1]); w.w = pk2(v1[2], v1[3]);
                        *(u32x4*)(ring + (rl + ai * HALF + m * 16) * 256 + cl + bj * HALF) = w; }
        } else {
            const int row0 = u.pm * BM + rl, br = u.pn >> 2, colo = (u.pn & 3) * BM + cl;
#pragma unroll
            for (int ai = 0; ai < 2; ++ai)
#pragma unroll
                for (int m = 0; m < 4; ++m) { const size_t row = (size_t)(row0 + ai * HALF + m * 16);
#pragma unroll
                    for (int bj = 0; bj < 2; ++bj) { const f32x4 v0 = acc[ai][bj][m][0], v1 = acc[ai][bj][m][1];
                        const u32x4 y = *(const u32x4*)(ring + (rl + ai * HALF + m * 16) * 256 + cl + bj * HALF);
                        float f[8];
                        f[0] = sigmf(v0[0]) * bflo(y.x); f[1] = sigmf(v0[1]) * bfhi(y.x); f[2] = sigmf(v0[2]) * bflo(y.y); f[3] = sigmf(v0[3]) * bfhi(y.y);
                        f[4] = sigmf(v1[0]) * bflo(y.z); f[5] = sigmf(v1[1]) * bfhi(y.z); f[6] = sigmf(v1[2]) * bflo(y.w); f[7] = sigmf(v1[3]) * bfhi(y.w);
                        bf16_t* sp = ring2 + (rl + ai * HALF + m * 16) * 256 + cl + bj * HALF;
                        if (br > 0) { float o[8]; unpack8(*(const u32x4*)sp, o);
#pragma unroll
                            for (int e = 0; e < 8; ++e) f[e] += o[e]; }
                        *(u32x4*)(br == 2 ? O + row * 1024 + colo + bj * HALF : sp) = pack8(f); } }
        }
    }
};
struct EpiRes {
    const bf16_t* res_bf; bf16_t* out_bf; const float* gate;
    __device__ __forceinline__ void operator()(const Acc& acc, const Unit& u, int wr, int wc, int fr, int fq) const {
        const int row0 = u.pm * BM + wr * 64 + fr, colb = u.pn * BM + wc * 32 + 8 * fq;
        const int gr = (u.pm * BM) >> 13;
        f32x4 gv[2][2];
#pragma unroll
        for (int bj = 0; bj < 2; ++bj)
#pragma unroll
            for (int n = 0; n < 2; ++n) gv[bj][n] = *(const f32x4*)(gate + gr * 6144 + colb + bj * HALF + 4 * n);
#pragma unroll
        for (int ai = 0; ai < 2; ++ai)
#pragma unroll
            for (int m = 0; m < 4; ++m) { const size_t ro = (size_t)(row0 + ai * HALF + m * 16) * 1024 + colb;
#pragma unroll
                for (int bj = 0; bj < 2; ++bj) { const u32x4 rv = *(const u32x4*)(res_bf + ro + bj * HALF);
                    const f32x4 a0 = gv[bj][0] * acc[ai][bj][m][0], a1 = gv[bj][1] * acc[ai][bj][m][1];
                    u32x4 w; w.x = pk2(bflo(rv.x) + a0[0], bfhi(rv.x) + a0[1]); w.y = pk2(bflo(rv.y) + a0[2], bfhi(rv.y) + a0[3]);
                    w.z = pk2(bflo(rv.z) + a1[0], bfhi(rv.z) + a1[1]); w.w = pk2(bflo(rv.w) + a1[2], bfhi(rv.w) + a1[3]);
                    *(u32x4*)(out_bf + ro + bj * HALF) = w; } }
    }
};
struct EpiSwi {
    bf16_t* H;
    __device__ __forceinline__ void operator()(const Acc& acc, const Unit& u, int wr, int wc, int fr, int fq) const {
        const int row0 = u.pm * BM + wr * 64 + fr, colb = u.pn * HALF + wc * 32 + 8 * fq;
#pragma unroll
        for (int ai = 0; ai < 2; ++ai)
#pragma unroll
            for (int m = 0; m < 4; ++m) { bf16_t* rowp = H + (size_t)(row0 + ai * HALF + m * 16) * DFF + colb;
                const f32x4 g0 = acc[ai][0][m][0], g1 = acc[ai][0][m][1], u0 = acc[ai][1][m][0], u1 = acc[ai][1][m][1];
                u32x4 w;
                w.x = pk2(siluf(g0[0]) * u0[0], siluf(g0[1]) * u0[1]); w.y = pk2(siluf(g0[2]) * u0[2], siluf(g0[3]) * u0[3]);
                w.z = pk2(siluf(g1[0]) * u1[0], siluf(g1[1]) * u1[1]); w.w = pk2(siluf(g1[2]) * u1[2], siluf(g1[3]) * u1[3]);
                *(u32x4*)rowp = w; }
    }
};

template <int NN, int NSPLIT, int BMOD> struct CtxOrder {
    int G, c, a_step, b_step, a_thresh, a_bytes, pn_off, a_base;
    __device__ bool next(int i, Unit& u) const {
        const int L = i * G + c; if (L >= 4 * NN * NSPLIT) return false;
        const int ks = L % NSPLIT, t = L / NSPLIT; u.pn = t % NN + pn_off; u.pm = 128 + t / NN; u.ks = ks; u.kind = 0; u.nt = 0; u.aoff = a_base + ks * a_step + (u.pn >= a_thresh ? a_bytes : 0); u.boff = (BMOD ? (ks % BMOD) : ks) * b_step; return true;
    }
};
struct EpiZ {
    bf16_t* Z;
    __device__ __forceinline__ void operator()(const Acc& acc, const Unit& u, int wr, int wc, int fr, int fq) const {
        const int row0 = u.pm * BM + wr * 64 + fr, colb = u.pn * BM + wc * 32 + 8 * fq;
#pragma unroll
        for (int ai = 0; ai < 2; ++ai)
#pragma unroll
            for (int m = 0; m < 4; ++m) { bf16_t* rowp = Z + (size_t)(row0 + ai * HALF + m * 16) * 3072 + colb;
#pragma unroll
                for (int bj = 0; bj < 2; ++bj) { const f32x4 v0 = acc[ai][bj][m][0], v1 = acc[ai][bj][m][1];
                    const u32x4 y = *(const u32x4*)(rowp + bj * HALF);
                    u32x4 w;
                    w.x = pk2(sigmf(v0[0]) * bflo(y.x), sigmf(v0[1]) * bfhi(y.x)); w.y = pk2(sigmf(v0[2]) * bflo(y.y), sigmf(v0[3]) * bfhi(y.y));
                    w.z = pk2(sigmf(v1[0]) * bflo(y.z), sigmf(v1[1]) * bfhi(y.z)); w.w = pk2(sigmf(v1[2]) * bflo(y.w), sigmf(v1[3]) * bfhi(y.w));
                    *(u32x4*)(rowp + bj * HALF) = w; } }
    }
};
struct CtxPairOrder {
    int G, c;
    __device__ bool next(int i, Unit& u) const {
        const int t = (i >> 1) * G + c; if (t >= 48) return false;
        u.kind = i & 1; u.pn = t % 12; u.pm = 128 + t / 12; u.boff = 0; u.ks = 0;
        const int br = u.pn >> 2; u.aoff = u.kind ? 0 : (br == 0 ? 0 : (br == 1 ? 1024 : 1536)); u.nt = u.kind ? 16 : (br == 0 ? 8 : 4); return true;
    }
};
struct EpiYZ {
    bf16_t* Ycat;
    __device__ __forceinline__ void operator()(const Acc& acc, const Unit& u, int wr, int wc, int fr, int fq) const {
        if (u.kind == 0) { EpiY e{Ycat, 3072}; e(acc, u, wr, wc, fr, fq); } else { EpiZ e{Ycat}; e(acc, u, wr, wc, fr, fq); }
    }
};
struct EpiPart {
    float* part; int nsplit_unused;
    __device__ __forceinline__ void operator()(const Acc& acc, const Unit& u, int wr, int wc, int fr, int fq) const {
        const int row0 = (u.pm - 128) * BM + wr * 64 + fr, colb = u.pn * BM + wc * 32 + 8 * fq;
        float* base = part + (size_t)u.ks * (MC * 1024) + (size_t)row0 * 1024 + colb;
#pragma unroll
        for (int ai = 0; ai < 2; ++ai)
#pragma unroll
            for (int m = 0; m < 4; ++m) { float* ro = base + (size_t)(ai * HALF + m * 16) * 1024;
#pragma unroll
                for (int bj = 0; bj < 2; ++bj)
#pragma unroll
                    for (int n = 0; n < 2; ++n) *(f32x4*)(ro + bj * HALF + 4 * n) = acc[ai][bj][m][n]; }
    }
};
}

__device__ __forceinline__ const float* wsrc(const Params& p, int l, int buf, int n, int k) {
    switch (buf) {
    case 0: { int c;
        if (n < 2048) c = n; else if (n < 2304) c = n + 16;
        else if (n < 2816) { const int t = (n - 2304) >> 8, w = (n - 2304) & 255; c = w < 128 ? 2320 + t * 128 + w : 2832 + t * 128 + (w - 128); }
        else if (n < 3072) c = n - 240; else c = n < 3088 ? n - 1024 : -1;
        if (c < 0) return nullptr; return p.w_in + (size_t)l * 1024 * NIN + (size_t)k * NIN + c; }
    case 1: return p.w_in + (size_t)l * 1024 * NIN + (size_t)k * NIN + 3088 + n;
    case 2: { const int br = n >> 10, nn = n & 1023;
        if (br == 0) return p.w_br_a + (size_t)l * 512 * 1024 + (size_t)k * 1024 + nn;
        if (br == 1) return k < 256 ? p.w_br_b + (size_t)l * 256 * 1024 + (size_t)k * 1024 + nn : nullptr;
        return k < 256 ? p.w_br_c + (size_t)l * 256 * 1024 + (size_t)k * 1024 + nn : nullptr; }
    case 3: return p.w_o + (size_t)l * 1024 * 1024 + (size_t)k * 1024 + n;
    case 4: { const int t = n >> 8, w = n & 255; const int c = w < 128 ? t * 128 + w : DFF + t * 128 + (w - 128); return p.w_gu + (size_t)l * 1024 * 2 * DFF + (size_t)k * 2 * DFF + c; }
    default: return p.w_down + (size_t)l * DFF * 1024 + (size_t)k * 1024 + n;
    }
}
struct CvtTile { int buf, K, n0, k0, pitch; size_t off; };
__device__ __forceinline__ CvtTile cvt_decode(int item) {
    const int cumt[7] = {0, 832, 1600, 1984, 2240, 3648, 4352};
    const int Ks[6] = {1024, 1024, 512, 1024, 1024, 2816};
    const size_t offs[6] = {WS_WIN1, WS_WG, WS_WBR, WS_WO3, WS_WGU, WS_WDN};
    CvtTile t; t.buf = 0;
#pragma unroll
    for (int b = 1; b < 6; ++b) if (item >= cumt[b]) t.buf = b;
    t.K = 1024; int base = 0; t.off = WS_WIN1;
#pragma unroll
    for (int b = 0; b < 6; ++b) if (t.buf == b) { t.K = Ks[b]; base = cumt[b]; t.off = offs[b]; }
    const int it = item - base, nkt = t.K / 64; t.k0 = (it % nkt) * 64; t.n0 = (it / nkt) * 64; t.pitch = (t.buf == 2) ? 1024 : t.K; return t;
}
__device__ void cvt_phase(const Params& p, unsigned char* ws_, int l, unsigned char* sm, int wvs_) {
    float* tile = (float*)sm;
    const int tid = opaque_tid(wvs_);
    constexpr int NT_ALL = 4352;
    for (int item = bid_(); item < NT_ALL; item += 2 * gdim_()) {
        CvtTile T[2]; T[0] = cvt_decode(item); const bool has2 = item + gdim_() < NT_ALL; T[1] = cvt_decode(has2 ? item + gdim_() : item);
        f32x4 v[2][2];
#pragma unroll
        for (int q = 0; q < 2; ++q)
#pragma unroll
            for (int r = 0; r < 2; ++r) { const int f4i = tid + 512 * r, kk = f4i >> 4, n4 = (f4i & 15) * 4;
                const float* src = wsrc(p, l, T[q].buf, T[q].n0 + n4, T[q].k0 + kk); v[q][r] = src ? *(const f32x4*)src : (f32x4){0.f, 0.f, 0.f, 0.f}; }
#pragma unroll
        for (int q = 0; q < 2; ++q)
#pragma unroll
            for (int r = 0; r < 2; ++r) { const int f4i = tid + 512 * r, kk = f4i >> 4, n4 = (f4i & 15) * 4;
#pragma unroll
                for (int e = 0; e < 4; ++e) tile[q * 4160 + kk * 65 + n4 + e] = v[q][r][e]; }
        __syncthreads();
#pragma unroll
        for (int q = 0; q < 2; ++q) { if (q == 0 || has2) { const int nn = tid >> 3, kg = tid & 7; float f[8];
#pragma unroll
            for (int i = 0; i < 8; ++i) f[i] = tile[q * 4160 + (kg * 8 + i) * 65 + nn];
            *(u32x4*)((bf16_t*)(ws_ + T[q].off) + (size_t)(T[q].n0 + nn) * T[q].pitch + T[q].k0 + kg * 8) = pack8(f); } }
        __syncthreads();
    }
}

__device__ void mod_phase(const Params& p, unsigned char* ws_, unsigned char* sm, int wvs_) {
    float* scv = (float*)sm; float* red = scv + 5120; float* mod = (float*)(ws_ + WS_MOD);
    const int tid = opaque_tid(wvs_);
    for (int i = tid; i < 5120; i += 512) { const int r = i >> 10, k = i & 1023; const float v = r < 4 ? p.c[r * 1024 + k] : p.c_ctx[k]; scv[i] = siluf(v); }
    __syncthreads();
    for (int item = bid_(); item < 192; item += gdim_()) {
        const int l = item / 96, cb = item % 96, cn = tid & 63, kg = tid >> 6, n = cb * 64 + cn;
        const float* W = p.w_ada + (size_t)l * 1024 * 6144;
        float a0 = 0, a1 = 0, a2 = 0, a3 = 0, a4 = 0;
        for (int kk = 0; kk < 128; ++kk) { const int k = kg * 128 + kk; const float w = W[(size_t)k * 6144 + n];
            a0 += scv[k] * w; a1 += scv[1024 + k] * w; a2 += scv[2048 + k] * w; a3 += scv[3072 + k] * w; a4 += scv[4096 + k] * w; }
        red[(kg * 5 + 0) * 64 + cn] = a0; red[(kg * 5 + 1) * 64 + cn] = a1; red[(kg * 5 + 2) * 64 + cn] = a2; red[(kg * 5 + 3) * 64 + cn] = a3; red[(kg * 5 + 4) * 64 + cn] = a4;
        __syncthreads();
        if (tid < 320) { const int r = tid >> 6, c2 = tid & 63; float s = 0; for (int q = 0; q < 8; ++q) s += red[(q * 5 + r) * 64 + c2];
            mod[(size_t)(l * 5 + r) * 6144 + cb * 64 + c2] = s + p.b_ada[l * 6144 + cb * 64 + c2]; }
        __syncthreads();
    }
}

__device__ __forceinline__ const float* mod_rowptr(const float* src_lat, const float* src_ctx, int row) { return row < ML ? src_lat + (size_t)row * 1024 : src_ctx + (size_t)(row - ML) * 1024; }
__device__ void modulate_phase(const Params& p, unsigned char* ws_, int l, int which, const float* src_lat, const bf16_t* src_lat_bf, bf16_t* copy_lat_bf, const float* src_ctx, int nrows, float* copy_ctx, const float* part, int nsplit, const float* pgate, int wvs_) {
    const int tid = opaque_tid(wvs_), wave = tid >> 6, lane = tid & 63;
    const float* mod = (const float*)(ws_ + WS_MOD); bf16_t* hb = (bf16_t*)(ws_ + WS_H);
    const float* g = (which == 1 ? p.norm1_g : p.norm2_g) + l * 1024;
    const int rstride = gdim_() * 8;
    for (int row0 = bid_() * 8 + wave; row0 < nrows; row0 += 3 * rstride) {
        f32x4 vv[3][4];
#pragma unroll
        for (int k = 0; k < 3; ++k) { const int row = min(row0 + k * rstride, nrows - 1);
            if (src_lat_bf && row < ML) {
#pragma unroll
                for (int j = 0; j < 4; ++j) { const u32x2 w2 = *(const u32x2*)(src_lat_bf + (size_t)row * 1024 + j * 256 + lane * 4); vv[k][j] = (f32x4){bflo(w2.x), bfhi(w2.x), bflo(w2.y), bfhi(w2.y)}; } }
            else { const float* xr = mod_rowptr(src_lat, src_ctx, row);
#pragma unroll
                for (int j = 0; j < 4; ++j) vv[k][j] = *(const f32x4*)(xr + j * 256 + lane * 4); } }
#pragma unroll
        for (int k = 0; k < 3; ++k) { const int row = row0 + k * rstride; if (row < nrows) {
            const int mr = row < ML ? (row >> 13) : 4;
            const float* shift = mod + (size_t)(l * 5 + mr) * 6144 + (which == 1 ? 0 : 3072); const float* scale = shift + 1024;
            f32x4 v[4]; float ss = 0.f;
#pragma unroll
            for (int j = 0; j < 4; ++j) { v[j] = vv[k][j]; ss += v[j][0] * v[j][0] + v[j][1] * v[j][1] + v[j][2] * v[j][2] + v[j][3] * v[j][3]; }
            if (part && row >= ML) {
                ss = 0.f;
#pragma unroll
                for (int j = 0; j < 4; ++j) { const int col = j * 256 + lane * 4; f32x4 a4 = {0.f, 0.f, 0.f, 0.f};
                    for (int ks = 0; ks < nsplit; ++ks) a4 += *(const f32x4*)(part + (size_t)ks * (MC * 1024) + (size_t)(row - ML) * 1024 + col);
                    v[j] += *(const f32x4*)(pgate + col) * a4;
                    ss += v[j][0] * v[j][0] + v[j][1] * v[j][1] + v[j][2] * v[j][2] + v[j][3] * v[j][3]; } }
            if (copy_lat_bf && row < ML) {
#pragma unroll
                for (int j = 0; j < 4; ++j) { u32x2 w2; w2.x = pk2(v[j][0], v[j][1]); w2.y = pk2(v[j][2], v[j][3]); *(u32x2*)(copy_lat_bf + (size_t)row * 1024 + j * 256 + lane * 4) = w2; } }
            if (copy_ctx && row >= ML) {
#pragma unroll
                for (int j = 0; j < 4; ++j) *(f32x4*)(copy_ctx + (size_t)(row - ML) * 1024 + j * 256 + lane * 4) = v[j]; }
#pragma unroll
            for (int o = 32; o >= 1; o >>= 1) ss += lane_get(ss, lane ^ o);
            const float rstd = rsqrtf(ss * (1.f / 1024.f) + EPS);
#pragma unroll
            for (int j = 0; j < 4; ++j) { const int col = j * 256 + lane * 4;
                const f32x4 gg = *(const f32x4*)(g + col), sc = *(const f32x4*)(scale + col), sh = *(const f32x4*)(shift + col);
                float y[4];
#pragma unroll
                for (int e = 0; e < 4; ++e) y[e] = v[j][e] * rstd * gg[e] * (1.f + sc[e]) + sh[e];
                u32x2 w; w.x = pk2(y[0], y[1]); w.y = pk2(y[2], y[3]);
                *(u32x2*)(hb + (size_t)row * 1024 + col) = w; } } }
    }
}

__device__ void branch_phase(const Params& p, unsigned char* ws_, const bf16_t* prest, int l, int nrows, unsigned char* sm, int wvs_) {
    const int tid = opaque_tid(wvs_), wv = __builtin_amdgcn_readfirstlane(tid >> 6), lane = tid & 63, fr = lane & 15, fq = lane >> 4;
    sm += (tid >> 10);
    bf16_t* bout = (bf16_t*)(ws_ + WS_BOUT);
    { const int gd = gdim_(), bd = bid_(), nextra = (NCHUNK * 4) % gd;
      const int n = nrows * 32, stride = (gd - nextra) * 512; const float* cw = p.sc_conv_w + l * 768;
      for (int i0 = (bd >= nextra) ? (bd - nextra) * 512 + tid : n; i0 < n; i0 += stride * 4) {
          u32x4 v0[4], vb[4], vm[4], vp[4];
#pragma unroll
          for (int k = 0; k < 4; ++k) { const int idx = min(i0 + k * stride, n - 1), tok = idx >> 5, c = (idx & 31) * 8;
              const bf16_t* r0 = prest + (size_t)tok * 768; const bf16_t* rm = seq_first(tok) ? r0 : r0 - 768; const bf16_t* rp = seq_last(tok) ? r0 : r0 + 768;
              v0[k] = *(const u32x4*)(r0 + 256 + c); vb[k] = *(const u32x4*)(r0 + 512 + c); vm[k] = *(const u32x4*)(rm + 256 + c); vp[k] = *(const u32x4*)(rp + 256 + c); }
#pragma unroll
          for (int k = 0; k < 4; ++k) { const int idx = i0 + k * stride; if (idx < n) { const int tok = idx >> 5, c = (idx & 31) * 8; const bool fst = seq_first(tok), lst = seq_last(tok);
              float a0[8], b0[8], am[8], ap[8], y[8];
              unpack8(v0[k], a0); unpack8(vb[k], b0); unpack8(vm[k], am); unpack8(vp[k], ap);
#pragma unroll
              for (int e = 0; e < 8; ++e) y[e] = b0[e] * ((fst ? 0.f : am[e]) * cw[c + e] + a0[e] * cw[256 + c + e] + (lst ? 0.f : ap[e]) * cw[512 + c + e]);
              *(u32x4*)(bout + (size_t)tok * 1024 + 768 + c) = pack8(y); } } } }
    float* V = (float*)sm; bf16_t* Dm = (bf16_t*)(sm + 16640); bf16_t* WpT = (bf16_t*)(sm + 16640 + 9216);
    const int nitems = (nrows > ML) ? (512 + 16) * 4 : 512 * 4;
    for (int item = bid_(); item < nitems; item += gdim_()) {
        const int gi = item & 3, rb = item >> 2, w = 2 << gi, lo = w >> 1, hi = w - 1 - lo;
        { const int ch = tid >> 3, dd0 = (tid & 7) * 8; const float* wp = p.pool_w + (size_t)(l * 4 + gi) * 4096 + ch * 64 + dd0;
          const f32x4 w0 = *(const f32x4*)wp, w1 = *(const f32x4*)(wp + 4);
#pragma unroll
          for (int e = 0; e < 4; ++e) { WpT[(dd0 + e) * 72 + ch] = (bf16_t)f2bf(w0[e]); WpT[(dd0 + 4 + e) * 72 + ch] = (bf16_t)f2bf(w1[e]); } }
        const int c = tid >> 3, cg8 = tid & 7, ch0 = cg8 * 8, colb = gi * 64 + ch0;
        float own[8], acc[8], d[8]; int tokbase;
#pragma unroll
        for (int e = 0; e < 8; ++e) acc[e] = 0.f;
        if (rb < 512) {
            const int b = rb >> 7, r = rb & 127, r0 = max(r - lo, 0), r1 = min(r + hi, 127); tokbase = b * SEQ + r * 64;
            u32x4 vv[16];
#pragma unroll
            for (int k = 0; k < 16; ++k) { const int rr = min(r0 + k, r1); vv[k] = *(const u32x4*)(prest + (size_t)(b * SEQ + rr * 64 + c) * 768 + colb); }
            unpack8(*(const u32x4*)(prest + (size_t)(tokbase + c) * 768 + colb), own);
#pragma unroll
            for (int k = 0; k < 16; ++k) { if (r0 + k <= r1) { float f[8]; unpack8(vv[k], f);
#pragma unroll
                for (int e = 0; e < 8; ++e) acc[e] += f[e]; } }
#pragma unroll
            for (int e = 0; e < 8; ++e) V[c * 65 + ch0 + e] = acc[e];
            __syncthreads();
            const int c0 = max(c - lo, 0), c1 = min(c + hi, 63); const float inv = 1.f / (float)((r1 - r0 + 1) * (c1 - c0 + 1));
            float s8[8];
#pragma unroll
            for (int e = 0; e < 8; ++e) s8[e] = 0.f;
            for (int cc = c0; cc <= c1; ++cc) {
#pragma unroll
                for (int e = 0; e < 8; ++e) s8[e] += V[cc * 65 + ch0 + e]; }
#pragma unroll
            for (int e = 0; e < 8; ++e) d[e] = s8[e] * inv - own[e];
        } else {
            const int cb = rb - 512, b = cb >> 2, s0 = (cb & 3) * 64 + c, sa = max(s0 - lo, 0), sb = min(s0 + hi, CTXL - 1); tokbase = ML + cb * 64;
            u32x4 vv[16];
#pragma unroll
            for (int k = 0; k < 16; ++k) { const int s2 = min(sa + k, sb); vv[k] = *(const u32x4*)(prest + (size_t)(ML + b * CTXL + s2) * 768 + colb); }
            unpack8(*(const u32x4*)(prest + (size_t)(tokbase + c) * 768 + colb), own);
#pragma unroll
            for (int k = 0; k < 16; ++k) { if (sa + k <= sb) { float f[8]; unpack8(vv[k], f);
#pragma unroll
                for (int e = 0; e < 8; ++e) acc[e] += f[e]; } }
            const float inv = 1.f / (float)(sb - sa + 1);
#pragma unroll
            for (int e = 0; e < 8; ++e) d[e] = acc[e] * inv - own[e];
            __syncthreads();
        }
        *(u32x4*)(Dm + c * 72 + ch0) = pack8(d);
        __syncthreads();
        { const int mt = wv & 3; const float* ps = p.pool_scale + l * 256 + gi * 64;
          const bf16x8 d0 = *(const bf16x8*)(Dm + (mt * 16 + fr) * 72 + fq * 8), d1 = *(const bf16x8*)(Dm + (mt * 16 + fr) * 72 + 32 + fq * 8);
#pragma unroll
          for (int q = 0; q < 2; ++q) { const int nt = (wv >> 2) * 2 + q; f32x4 o = {0.f, 0.f, 0.f, 0.f};
              o = __builtin_amdgcn_mfma_f32_16x16x32_bf16(*(const bf16x8*)(WpT + (nt * 16 + fr) * 72 + fq * 8), d0, o, 0, 0, 0);
              o = __builtin_amdgcn_mfma_f32_16x16x32_bf16(*(const bf16x8*)(WpT + (nt * 16 + fr) * 72 + 32 + fq * 8), d1, o, 0, 0, 0);
              const f32x4 sc = *(const f32x4*)(ps + nt * 16 + fq * 4);
              u32x2 wo; wo.x = pk2(o[0] * sc[0], o[1] * sc[1]); wo.y = pk2(o[2] * sc[2], o[3] * sc[3]);
              *(u32x2*)(bout + (size_t)(tokbase + mt * 16 + fr) * 1024 + 512 + gi * 64 + nt * 16 + fq * 4) = wo; } }
        __syncthreads();
    }
}

__device__ void prep_phase(const Params& p, unsigned char* ws_, int l, unsigned char* sm, int wvs_) {
    constexpr int OFF_Q = 0, OFF_K = 17408, OFF_VT = 36864, OFF_KT = 55296, OFF_A = 73728, OFF_G = 106496, OFF_TF = 108544;
    const int tid0_ = opaque_tid(wvs_); sm += (tid0_ >> 10);
    bf16_t* qS = (bf16_t*)(sm + OFF_Q); bf16_t* kS = (bf16_t*)(sm + OFF_K); bf16_t* TS = (bf16_t*)sm;
    bf16_t* vT = (bf16_t*)(sm + OFF_VT); bf16_t* kT = (bf16_t*)(sm + OFF_KT);
    float* Lm = (float*)(sm + OFF_A); float* Tm = (float*)(sm + OFF_TF); float* Xs = (float*)sm; float* gS = (float*)(sm + OFF_G); float* betaS = gS + 128; float* gcS = gS + 256;
    const int tid = opaque_tid(wvs_), wv = __builtin_amdgcn_readfirstlane(tid >> 6), lane = tid & 63, fr = lane & 15, fq = lane >> 4;
    const bf16_t* pq = (const bf16_t*)(ws_ + WS_PQ); const float* ab = (const float*)(ws_ + WS_AB);
    bf16_t* qn = (bf16_t*)(ws_ + WS_QN); bf16_t* kTg = (bf16_t*)(ws_ + WS_KT);
    float* gcg = (float*)(ws_ + WS_GC);
    const float* cw = p.dn_conv_w + (size_t)l * 3 * 1536;
    for (int item = bid_(); item < NCHUNK * 4; item += gdim_()) {
        const int g = item >> 2, h = item & 3, t0 = g * 64;
        if (tid < 128) { const int d = tid >> 6, i = tid & 63; const float a = ab[(size_t)(t0 + i) * 16 + d * 4 + h], bb = ab[(size_t)(t0 + i) * 16 + 8 + d * 4 + h];
            const float z = a + p.dn_dt_bias[l * 8 + d * 4 + h]; const float sp = fmaxf(z, 0.f) + log1pf(__expf(-fabsf(z)));
            float x = -__expf(p.dn_a_log[l * 8 + d * 4 + h]) * sp; betaS[d * 64 + i] = sigmf(bb);
#pragma unroll
            for (int off = 1; off < 64; off <<= 1) { const float up = lane_get(x, (i - off) & 63), dn = lane_get(x, (i + off) & 63);
                if (d == 0) { if (i >= off) x += up; } else { if (i + off < 64) x += dn; } }
            gcS[d * 64 + i] = x; gcg[((size_t)d * MT + t0 + i) * 4 + h] = x; }
        { const int i = tid >> 3, cg8 = tid & 7, t = t0 + i; const bool fst = seq_first(t), lst = seq_last(t);
#pragma unroll
          for (int part = 0; part < 3; ++part) {
              const int col = part * 512 + h * 128 + cg8 * 16; const bf16_t* r0 = pq + (size_t)t * 1536 + col;
              float x0[16], xm[16], xp[16], v[16];
              unpack8(*(const u32x4*)r0, x0); unpack8(*(const u32x4*)(r0 + 8), x0 + 8);
              if (!fst) { unpack8(*(const u32x4*)(r0 - 1536), xm); unpack8(*(const u32x4*)(r0 - 1536 + 8), xm + 8); }
              if (!lst) { unpack8(*(const u32x4*)(r0 + 1536), xp); unpack8(*(const u32x4*)(r0 + 1536 + 8), xp + 8); }
              float ss = 0.f;
#pragma unroll
              for (int e = 0; e < 16; ++e) { const float a = (fst ? 0.f : xm[e]) * cw[col + e] + x0[e] * cw[1536 + col + e] + (lst ? 0.f : xp[e]) * cw[3072 + col + e];
                  v[e] = siluf(a); ss += v[e] * v[e]; }
              if (part < 2) { ss += lane_get(ss, lane ^ 1); ss += lane_get(ss, lane ^ 2); ss += lane_get(ss, lane ^ 4);
                  const float rn = rsqrtf(ss + EPS) * (part == 0 ? 0.08838834764831845f : 1.f);
#pragma unroll
                  for (int e = 0; e < 16; ++e) v[e] *= rn; }
              if (part == 0) { const u32x4 w0 = pack8(v), w1 = pack8(v + 8);
                  *(u32x4*)(qS + i * 136 + cg8 * 16) = w0; *(u32x4*)(qS + i * 136 + cg8 * 16 + 8) = w1;
                  *(u32x4*)(qn + (size_t)t * 512 + h * 128 + cg8 * 16) = w0; *(u32x4*)(qn + (size_t)t * 512 + h * 128 + cg8 * 16 + 8) = w1; }
              else if (part == 1) { *(u32x4*)(kS + i * 136 + cg8 * 16) = pack8(v); *(u32x4*)(kS + i * 136 + cg8 * 16 + 8) = pack8(v + 8);
#pragma unroll
                  for (int e = 0; e < 16; ++e) kT[(cg8 * 16 + e) * 72 + i] = (bf16_t)f2bf(v[e]); }
              else {
#pragma unroll
                  for (int e = 0; e < 16; ++e) vT[(cg8 * 16 + e) * 72 + i] = (bf16_t)f2bf(v[e]); }
          } }
        __syncthreads();
        { const int j = tid >> 2, part = tid & 3; bf16_t* dst = kTg + ((size_t)(g * 4 + h) * 128 + j) * 64 + part * 16;
          *(u32x4*)dst = *(const u32x4*)(kT + j * 72 + part * 16); *(u32x4*)(dst + 8) = *(const u32x4*)(kT + j * 72 + part * 16 + 8); }
        { const int mt = wv & 3; const bf16_t* XS = (wv < 4) ? qS : kS; const int i = mt * 16 + fr;
          bf16x8 af[4];
#pragma unroll
          for (int ks = 0; ks < 4; ++ks) af[ks] = *(const bf16x8*)(XS + (mt * 16 + fr) * 136 + ks * 32 + fq * 8);
          const float gi0 = gcS[i], gi1 = gcS[64 + i], bi0 = betaS[i], bi1 = betaS[64 + i];
#pragma unroll
          for (int nt = 0; nt < 4; ++nt) { f32x4 acc = {0.f, 0.f, 0.f, 0.f};
#pragma unroll
              for (int ks = 0; ks < 4; ++ks) { const bf16x8 bfr = *(const bf16x8*)(kS + (nt * 16 + fr) * 136 + ks * 32 + fq * 8);
                  acc = __builtin_amdgcn_mfma_f32_16x16x32_bf16(bfr, af[ks], acc, 0, 0, 0); }
              const int jb = nt * 16 + fq * 4;
#pragma unroll
              for (int d = 0; d < 2; ++d) { float v[4];
#pragma unroll
                  for (int j = 0; j < 4; ++j) { const int jj = jb + j; const float e = __expf(fminf((d ? gi1 : gi0) - gcS[d * 64 + jj], 0.f));
                      if (wv < 4) { const bool ok = d == 0 ? (i >= jj) : (i <= jj); v[j] = ok ? acc[j] * e : 0.f; }
                      else { const bool ok = d == 0 ? (i > jj) : (i < jj); v[j] = ok ? (d ? bi1 : bi0) * acc[j] * e : 0.f; } }
                  if (wv < 4) { u32x2 w; w.x = pk2(v[0], v[1]); w.y = pk2(v[2], v[3]);
                      *(u32x2*)((bf16_t*)(ws_ + WS_AQK + d * SZAQK) + ((size_t)(g * 4 + h) * 64 + i) * 64 + jb) = w; }
                  else { const int md = d ? 63 : 0;
#pragma unroll
                      for (int j = 0; j < 4; ++j) Lm[d * 4096 + (i ^ md) * 64 + ((jb + j) ^ md)] = v[j]; } } } }
        __syncthreads();
        if (tid < 128) { const int d = tid >> 6, blk = (tid >> 4) & 3, col = tid & 15; const float* Lb = Lm + d * 4096 + (blk * 16) * 64 + blk * 16; float tc[16];
#pragma unroll
            for (int r = 0; r < 16; ++r) { float s = (r == col) ? 1.f : 0.f;
#pragma unroll
                for (int j = 0; j < r; ++j) s -= Lb[r * 64 + j] * tc[j];
                tc[r] = s; }
            float* Tb = Tm + d * 4096 + (blk * 16) * 64 + blk * 16 + col;
#pragma unroll
            for (int r = 0; r < 16; ++r) Tb[r * 64] = tc[r]; }
        __syncthreads();
#pragma unroll
        for (int dist = 1; dist <= 3; ++dist) {
            const int nper = 4 - dist; const bool act = wv < 2 * nper;
            const int d = wv / nper, R = dist + wv % nper, C = R - dist;
            const float* Ld = Lm + d * 4096; float* Td = Tm + d * 4096;
            if (act) { f32x4 X = {0.f, 0.f, 0.f, 0.f};
                for (int K = C; K < R; ++K) {
#pragma unroll
                    for (int kk = 0; kk < 4; ++kk) X = __builtin_amdgcn_mfma_f32_16x16x4f32(Ld[(R * 16 + fr) * 64 + K * 16 + kk * 4 + fq], Td[(K * 16 + kk * 4 + fq) * 64 + C * 16 + fr], X, 0, 0, 0); }
#pragma unroll
                for (int j = 0; j < 4; ++j) Xs[wv * 256 + (fq * 4 + j) * 16 + fr] = X[j]; }
            __syncthreads();
            if (act) { f32x4 Y = {0.f, 0.f, 0.f, 0.f};
#pragma unroll
                for (int kk = 0; kk < 4; ++kk) Y = __builtin_amdgcn_mfma_f32_16x16x4f32(Td[(R * 16 + fr) * 64 + R * 16 + kk * 4 + fq], Xs[wv * 256 + (kk * 4 + fq) * 16 + fr], Y, 0, 0, 0);
#pragma unroll
                for (int j = 0; j < 4; ++j) Td[(R * 16 + fq * 4 + j) * 64 + C * 16 + fr] = -Y[j]; }
            __syncthreads();
        }
        for (int idx = tid; idx < 8192; idx += 512) { const int d = idx >> 12, ip = (idx >> 6) & 63, cp = idx & 63, md = d ? 63 : 0, i = ip ^ md, c = cp ^ md;
            const float tv = ((cp >> 4) > (ip >> 4)) ? 0.f : Tm[d * 4096 + ip * 64 + cp]; const float bc = betaS[d * 64 + c];
            TS[(d * 2) * 4608 + i * 72 + c] = (bf16_t)f2bf(tv * bc); TS[(d * 2 + 1) * 4608 + i * 72 + c] = (bf16_t)f2bf(tv * bc * __expf(gcS[d * 64 + c])); }
        __syncthreads();
        { const int d = wv >> 2, which = (wv >> 1) & 1; const bf16_t* Tm2 = TS + (d * 2 + which) * 4608; const bf16_t* XT = which ? kT : vT;
          bf16_t* dst = (bf16_t*)(ws_ + (which ? WS_WB : WS_UB) + d * SZ512);
#pragma unroll
          for (int mi = 0; mi < 2; ++mi) { const int mt = (wv & 1) * 2 + mi;
              const bf16x8 a0 = *(const bf16x8*)(Tm2 + (mt * 16 + fr) * 72 + fq * 8), a1 = *(const bf16x8*)(Tm2 + (mt * 16 + fr) * 72 + 32 + fq * 8);
              bf16_t* drow = dst + (size_t)(t0 + mt * 16 + fr) * 512 + h * 128 + fq * 4;
#pragma unroll
              for (int nt = 0; nt < 8; ++nt) { f32x4 acc = {0.f, 0.f, 0.f, 0.f};
                  acc = __builtin_amdgcn_mfma_f32_16x16x32_bf16(*(const bf16x8*)(XT + (nt * 16 + fr) * 72 + fq * 8), a0, acc, 0, 0, 0);
                  acc = __builtin_amdgcn_mfma_f32_16x16x32_bf16(*(const bf16x8*)(XT + (nt * 16 + fr) * 72 + 32 + fq * 8), a1, acc, 0, 0, 0);
                  u32x2 w; w.x = pk2(acc[0], acc[1]); w.y = pk2(acc[2], acc[3]);
                  *(u32x2*)(drow + nt * 16) = w; } } }
        __syncthreads();
    }
}

namespace scn {
constexpr int ST_W = 0, ST_Q = 17408, ST_KT = 34816, ST_AQK = 53248, ST_U = 62464, ST_GC = 64512, ST_SIZE = 64768;
constexpr int OFF_ST = 2 * ST_SIZE, OFF_VN = OFF_ST + 4352, OFF_VS = OFF_VN + 2304;
struct Regs { u32x4 w0, w1, q0, q1, k0, k1, a, u; float g; };
struct Ptrs { const char *wb, *ub, *qn, *kTg, *aq, *gcg; bf16_t* ob; unsigned vo_w, vo_a, vo_k, vo_u, vo_g, lo_w, lo_a, lo_k, lo_u, lo_g; };
__device__ __forceinline__ void setup(Ptrs& P, int h, int sl, int tid) {
    { const int i = tid >> 3, pt = tid & 7; P.vo_w = (unsigned)((i * 512 + h * 128 + pt * 16) * 2); P.vo_a = (unsigned)(((h * 64 + i) * 64 + pt * 8) * 2);
      P.lo_w = (unsigned)((i * 136 + pt * 16) * 2); P.lo_a = (unsigned)(ST_AQK + (i * 72 + pt * 8) * 2); }
    { const int j = tid >> 2, pt = tid & 3; P.vo_k = (unsigned)(((h * 128 + j) * 64 + pt * 16) * 2); P.lo_k = (unsigned)(ST_KT + (j * 72 + pt * 16) * 2); }
    P.vo_u = (unsigned)((((tid >> 1) & 63) * 512 + h * 128 + sl * 16 + (tid & 1) * 8) * 2); P.lo_u = (unsigned)(ST_U + (((tid >> 1) & 63) * 16 + (tid & 1) * 8) * 2);
    P.vo_g = (unsigned)(((tid & 63) * 4 + h) * 4); P.lo_g = (unsigned)(ST_GC + (tid & 63) * 4);
}
__device__ __forceinline__ void load1(Regs& r, const Ptrs& P, int g) {
    const size_t o512 = (size_t)g * (64 * 512 * 2);
    const char* pw = P.wb + o512 + P.vo_w; const char* pq = P.qn + o512 + P.vo_w;
    r.w0 = *(const u32x4*)pw; r.w1 = *(const u32x4*)(pw + 16); r.q0 = *(const u32x4*)pq;
}
__device__ __forceinline__ void load2(Regs& r, const Ptrs& P, int g) {
    const size_t o512 = (size_t)g * (64 * 512 * 2), okt = (size_t)g * (4 * 128 * 64 * 2);
    r.q1 = *(const u32x4*)(P.qn + o512 + P.vo_w + 16);
    const char* pk = P.kTg + okt + P.vo_k; r.k0 = *(const u32x4*)pk; r.k1 = *(const u32x4*)(pk + 16);
}
__device__ __forceinline__ void load3(Regs& r, const Ptrs& P, int g) {
    const size_t o512 = (size_t)g * (64 * 512 * 2), oaq = (size_t)g * (4 * 64 * 64 * 2), ogc = (size_t)g * (64 * 4 * 4);
    r.a = *(const u32x4*)(P.aq + oaq + P.vo_a);
    r.u = *(const u32x4*)(P.ub + o512 + P.vo_u);
    r.g = *(const float*)(P.gcg + ogc + P.vo_g);
}
__device__ __forceinline__ void load(Regs& r, const Ptrs& P, int g, int tid) { load1(r, P, g); load2(r, P, g); load3(r, P, g); }
__device__ __forceinline__ void store(const Regs& r, const Ptrs& P, unsigned char* b, int tid) {
    *(u32x4*)(b + ST_W + P.lo_w) = r.w0; *(u32x4*)(b + ST_W + P.lo_w + 16) = r.w1;
    *(u32x4*)(b + ST_Q + P.lo_w) = r.q0; *(u32x4*)(b + ST_Q + P.lo_w + 16) = r.q1;
    *(u32x4*)(b + P.lo_a) = r.a;
    *(u32x4*)(b + P.lo_k) = r.k0; *(u32x4*)(b + P.lo_k + 16) = r.k1;
    if (tid < 128) *(u32x4*)(b + P.lo_u) = r.u;
    if (tid < 64) *(float*)(b + P.lo_g) = r.g;
}
__device__ __forceinline__ void step(unsigned char* sm, const unsigned char* bs, f32x4& accS, const Ptrs& P, int g, int h, int sl, int d, int wv, int fr, int fq, Regs& rl, int gld) {
    bf16_t* StS = (bf16_t*)(sm + OFF_ST); bf16_t* vnT = (bf16_t*)(sm + OFF_VN); bf16_t* vsT = (bf16_t*)(sm + OFF_VS);
    const bf16_t* wS = (const bf16_t*)(bs + ST_W); const bf16_t* qS = (const bf16_t*)(bs + ST_Q); const bf16_t* kTS = (const bf16_t*)(bs + ST_KT);
    const bf16_t* aS = (const bf16_t*)(bs + ST_AQK); const bf16_t* uS = (const bf16_t*)(bs + ST_U); const float* gcS = (const float*)(bs + ST_GC);
    const int t0 = g * 64, mt = wv & 3;
    const float gl = gcS[d ? 0 : 63];
    load1(rl, P, gld);
    f32x4 acc1 = {0.f, 0.f, 0.f, 0.f};
    if (wv < 4) {
#pragma unroll
        for (int ks = 0; ks < 4; ++ks) acc1 = __builtin_amdgcn_mfma_f32_16x16x32_bf16(*(const bf16x8*)(wS + (mt * 16 + fr) * 136 + ks * 32 + fq * 8),
                                                                                       *(const bf16x8*)(StS + fr * 136 + ks * 32 + fq * 8), acc1, 0, 0, 0);
        float vn[4], vs[4];
#pragma unroll
        for (int j = 0; j < 4; ++j) { const int i = mt * 16 + fq * 4 + j; vn[j] = bf2f(uS[i * 16 + fr]) - acc1[j]; vs[j] = vn[j] * __expf(gl - gcS[i]); }
        u32x2 w1, w2; w1.x = pk2(vn[0], vn[1]); w1.y = pk2(vn[2], vn[3]); w2.x = pk2(vs[0], vs[1]); w2.y = pk2(vs[2], vs[3]);
        *(u32x2*)(vnT + fr * 72 + mt * 16 + fq * 4) = w1; *(u32x2*)(vsT + fr * 72 + mt * 16 + fq * 4) = w2;
    } else {
#pragma unroll
        for (int ks = 0; ks < 4; ++ks) acc1 = __builtin_amdgcn_mfma_f32_16x16x32_bf16(*(const bf16x8*)(StS + fr * 136 + ks * 32 + fq * 8),
                                                                                       *(const bf16x8*)(qS + (mt * 16 + fr) * 136 + ks * 32 + fq * 8), acc1, 0, 0, 0);
    }
    bf16x8 ka[2], aa[2];
#pragma unroll
    for (int ks = 0; ks < 2; ++ks) { ka[ks] = *(const bf16x8*)(kTS + (wv * 16 + fr) * 72 + ks * 32 + fq * 8); aa[ks] = *(const bf16x8*)(aS + (mt * 16 + fr) * 72 + ks * 32 + fq * 8); }
    const float egi = __expf(gcS[mt * 16 + fr]), egl = __expf(gl);
    __syncthreads();
    load2(rl, P, gld);
    if (wv >= 4) { f32x4 acc3 = {0.f, 0.f, 0.f, 0.f};
#pragma unroll
        for (int ks = 0; ks < 2; ++ks) acc3 = __builtin_amdgcn_mfma_f32_16x16x32_bf16(*(const bf16x8*)(vnT + fr * 72 + ks * 32 + fq * 8), aa[ks], acc3, 0, 0, 0);
        const int i = mt * 16 + fr;
        u32x2 w; w.x = pk2(egi * acc1[0] + acc3[0], egi * acc1[1] + acc3[1]); w.y = pk2(egi * acc1[2] + acc3[2], egi * acc1[3] + acc3[3]);
        *(u32x2*)(P.ob + (size_t)(t0 + i) * 512 + h * 128 + sl * 16 + fq * 4) = w; }
    { f32x4 accn = {0.f, 0.f, 0.f, 0.f};
#pragma unroll
      for (int ks = 0; ks < 2; ++ks) accn = __builtin_amdgcn_mfma_f32_16x16x32_bf16(ka[ks], *(const bf16x8*)(vsT + fr * 72 + ks * 32 + fq * 8), accn, 0, 0, 0);
#pragma unroll
      for (int j = 0; j < 4; ++j) accS[j] = accS[j] * egl + accn[j];
      u32x2 w; w.x = pk2(accS[0], accS[1]); w.y = pk2(accS[2], accS[3]);
      *(u32x2*)(StS + fr * 136 + wv * 16 + fq * 4) = w; }
    load3(rl, P, gld);
}
}

__device__ void scan_phase(const Params& p, unsigned char* ws_, unsigned char* sm, int wvs_) {
    using namespace scn;
    const int tid = opaque_tid(wvs_), wv = __builtin_amdgcn_readfirstlane(tid >> 6), lane = tid & 63, fr = lane & 15, fq = lane >> 4;
    sm += (tid >> 10);
    bf16_t* StS = (bf16_t*)(sm + OFF_ST);
    for (int wu = bid_(); wu < 256; wu += gdim_()) {
        const int xcd = wu & 7, idx = wu >> 3, chain = xcd * 4 + (idx >> 3), sl = idx & 7, b = chain >> 3, h = (chain >> 1) & 3, d = chain & 1;
        Ptrs P; P.wb = (const char*)(ws_ + WS_WB + d * SZ512); P.ub = (const char*)(ws_ + WS_UB + d * SZ512);
        P.qn = (const char*)(ws_ + WS_QN); P.kTg = (const char*)(ws_ + WS_KT);
        P.aq = (const char*)(ws_ + WS_AQK + d * SZAQK); P.gcg = (const char*)(ws_ + WS_GC) + (size_t)d * MT * 16;
        P.ob = (bf16_t*)(ws_ + WS_PQ + d * SZ512); setup(P, h, sl, tid);
        f32x4 accS = {0.f, 0.f, 0.f, 0.f};
        for (int i = tid; i < 16 * 136; i += 512) StS[i] = 0;
#define SCAN_CHUNK(n_) ((n_) < 4 ? 512 + b * 4 + (d ? 3 - (n_) : (n_)) : b * 128 + (d ? 127 - ((n_) - 4) : ((n_) - 4)))
        Regs rA, rB; rA.u = (u32x4){0u, 0u, 0u, 0u}; rB.u = rA.u; rA.g = 0.f; rB.g = 0.f;
        { const int g0 = SCAN_CHUNK(0); load(rA, P, g0, tid); store(rA, P, sm, tid); }
        { const int g1 = SCAN_CHUNK(1); load(rA, P, g1, tid); const int g2 = SCAN_CHUNK(2); load(rB, P, g2, tid); }
        __syncthreads();
        for (int n = 0; n < 132; n += 2) {
            store(rA, P, sm + ST_SIZE, tid);
            { const int g = SCAN_CHUNK(n); const int nn = min(n + 3, 131); const int gn = SCAN_CHUNK(nn); step(sm, sm, accS, P, g, h, sl, d, wv, fr, fq, rA, gn); }
            __syncthreads();
            store(rB, P, sm, tid);
            { const int g = SCAN_CHUNK(n + 1); const int nn = min(n + 4, 131); const int gn = SCAN_CHUNK(nn); step(sm, sm + ST_SIZE, accS, P, g, h, sl, d, wv, fr, fq, rB, gn); }
            __syncthreads();
        }
#undef SCAN_CHUNK
    }
}

__device__ void ofinal_phase(const Params& p, unsigned char* ws_, int l, int nrows, int wvs_) {
    const int tid = opaque_tid(wvs_);
    const bf16_t* o0 = (const bf16_t*)(ws_ + WS_PQ); const bf16_t* o1 = (const bf16_t*)(ws_ + WS_PQ + SZ512); bf16_t* bout = (bf16_t*)(ws_ + WS_BOUT);
    const float* g = p.dn_norm_g + l * 128;
    for (int base = bid_() * 8; base < nrows; base += gdim_() * 8) {
        const int tok = base + (tid >> 6), h = (tid >> 4) & 3, part = tid & 15, col = h * 128 + part * 8;
        float a[8], b[8], z[8];
        unpack8(*(const u32x4*)(o0 + (size_t)tok * 512 + col), a); unpack8(*(const u32x4*)(o1 + (size_t)tok * 512 + col), b);
        unpack8(*(const u32x4*)(bout + (size_t)tok * 1024 + col), z);
        float ss = 0.f;
#pragma unroll
        for (int e = 0; e < 8; ++e) { a[e] += b[e]; ss += a[e] * a[e]; }
        { const int ln = tid & 63; ss += lane_get(ss, ln ^ 1); ss += lane_get(ss, ln ^ 2); ss += lane_get(ss, ln ^ 4); ss += lane_get(ss, ln ^ 8); }
        const float rn = rsqrtf(ss * (1.f / 128.f) + EPS);
#pragma unroll
        for (int e = 0; e < 8; ++e) a[e] = a[e] * rn * g[part * 8 + e] * z[e];
        *(u32x4*)(bout + (size_t)tok * 1024 + col) = pack8(a);
    }
}

__device__ void final_phase(const Params& p, const bf16_t* xb, float* out_, int wvs_) {
    const int tid = opaque_tid(wvs_), wave = tid >> 6, lane = tid & 63;
    const int rstride = gdim_() * 8;
    for (int row0 = bid_() * 8 + wave; row0 < ML; row0 += 3 * rstride) {
        f32x4 vv[3][4];
#pragma unroll
        for (int k = 0; k < 3; ++k) { const int row = min(row0 + k * rstride, ML - 1);
#pragma unroll
            for (int j = 0; j < 4; ++j) { const u32x2 w2 = *(const u32x2*)(xb + (size_t)row * 1024 + j * 256 + lane * 4); vv[k][j] = (f32x4){bflo(w2.x), bfhi(w2.x), bflo(w2.y), bfhi(w2.y)}; } }
#pragma unroll
        for (int k = 0; k < 3; ++k) { const int row = row0 + k * rstride; if (row < ML) {
            float* xr = out_ + (size_t)row * 1024; float ss = 0.f;
#pragma unroll
            for (int j = 0; j < 4; ++j) ss += vv[k][j][0] * vv[k][j][0] + vv[k][j][1] * vv[k][j][1] + vv[k][j][2] * vv[k][j][2] + vv[k][j][3] * vv[k][j][3];
#pragma unroll
            for (int o = 32; o >= 1; o >>= 1) ss += lane_get(ss, lane ^ o);
            const float rstd = rsqrtf(ss * (1.f / 1024.f) + EPS);
#pragma unroll
            for (int j = 0; j < 4; ++j) { const int col = j * 256 + lane * 4; const f32x4 gg = *(const f32x4*)(p.final_norm_g + col);
                f32x4 y; y[0] = vv[k][j][0] * rstd * gg[0]; y[1] = vv[k][j][1] * rstd * gg[1]; y[2] = vv[k][j][2] * rstd * gg[2]; y[3] = vv[k][j][3] * rstd * gg[3];
                *(f32x4*)(xr + col) = y; } } }
    }
}

#define XB_TMO      128
#define XB_XCNT(j)  (256  + 64 * (j))
#define XB_XSUB(j)  (1280 + 64 * (j))
#define XB_XGEN(j)  (2304 + 64 * (j))
#define XB_TOP      3328
#define XB_TOPGEN   3392
#define XCD_BAR_WORDS 3456
#define XB_SPIN_CAP (1u << 20)
__device__ __forceinline__ unsigned xb_ld(unsigned* p)              { return __hip_atomic_load(p, __ATOMIC_RELAXED, __HIP_MEMORY_SCOPE_AGENT); }
__device__ __forceinline__ unsigned xb_add(unsigned* p, unsigned v) { return __hip_atomic_fetch_add(p, v, __ATOMIC_RELAXED, __HIP_MEMORY_SCOPE_AGENT); }
__device__ __forceinline__ unsigned xb_xcc_id() { return (unsigned)__builtin_amdgcn_s_getreg((3 << 11) | 20) & 0xFu; }
#define XB_SPIN(cond, bar) do { unsigned _sp = 0; while (cond) { \
    if ((++_sp & 255u) == 0u) { if (xb_ld(&(bar)[XB_TMO])) break; if (_sp > XB_SPIN_CAP) { atomicAdd(&(bar)[XB_TMO], 1u); break; } } } } while (0)
struct XcdBarrier { unsigned* bar; unsigned x; volatile LAS unsigned* st; };
__device__ __forceinline__ XcdBarrier xcd_barrier_post(unsigned* bar, volatile LAS unsigned* st) {
    XcdBarrier b; b.bar = bar; b.x = xb_xcc_id(); b.st = st;
    if (threadIdx.x == 0) (void)xb_add(&bar[XB_XCNT(b.x)], 1u);
    return b;
}
__device__ __forceinline__ void xcd_barrier_complete(unsigned* bar, unsigned x, unsigned& nloc, unsigned& nx) {
    const unsigned G = gridDim.x * gridDim.y * gridDim.z;
    unsigned sum, cnt, mine, sp = 0u;
    for (;;) {
        sum = 0u; cnt = 0u; mine = 0u;
#pragma unroll
        for (unsigned j = 0; j < 16; ++j) { const unsigned c = xb_ld(&bar[XB_XCNT(j)]); sum += c; cnt += (c > 0u) ? 1u : 0u; mine = (j == x) ? c : mine; }
        if (sum == G) break;
        __builtin_amdgcn_s_sleep(1);
        if ((++sp & 255u) == 0u) { if (xb_ld(&bar[XB_TMO])) break; if (sp > XB_SPIN_CAP) { atomicAdd(&bar[XB_TMO], 1u); break; } }
    }
    nloc = mine > 0u ? mine : 1u; nx = cnt > 0u ? cnt : 1u;
}
__device__ __forceinline__ void xcd_barrier(const XcdBarrier& b) {
    asm volatile("s_waitcnt vmcnt(0)" ::: "memory");
    __syncthreads();
    if (threadIdx.x == 0) {
        unsigned* bar = b.bar;
        __builtin_amdgcn_s_waitcnt(0);
        unsigned nloc = b.st[0], nx = b.st[1];
        if (nloc == 0u) { xcd_barrier_complete(bar, b.x, nloc, nx); b.st[0] = nloc; b.st[1] = nx; }
        const unsigned old = xb_add(&bar[XB_XSUB(b.x)], 1u);
        const unsigned gen = old / nloc;
        if (old + 1u == (gen + 1u) * nloc) {
            __builtin_amdgcn_fence(__ATOMIC_RELEASE, "agent");
            asm volatile("s_waitcnt vmcnt(0)" ::: "memory");
            const unsigned og = xb_add(&bar[XB_TOP], 1u);
            const unsigned tg = og / nx;
            if (og + 1u == (tg + 1u) * nx) xb_add(&bar[XB_TOPGEN], 1u);
            else XB_SPIN(xb_ld(&bar[XB_TOPGEN]) == tg, bar);
            __builtin_amdgcn_fence(__ATOMIC_ACQUIRE, "agent");
            xb_add(&bar[XB_XGEN(b.x)], 1u);
            asm volatile("s_waitcnt vmcnt(0)" ::: "memory");
        } else {
            XB_SPIN(xb_ld(&bar[XB_XGEN(b.x)]) == gen, bar);
            __builtin_amdgcn_fence(__ATOMIC_ACQUIRE, "agent");
            asm volatile("s_waitcnt vmcnt(0)" ::: "memory");
        }
    }
    __syncthreads();
}

#ifndef PROBE_MASK
#define PROBE_MASK 0u
#endif
#ifndef PH_MASK
#define PH_MASK 0xFFFF
#endif
constexpr int N_PHASES = 26;
__global__ void __launch_bounds__(512, 2) fwd_megakernel(Params pin) {
    extern __shared__ __attribute__((aligned(16))) unsigned char lds[];
    cg::grid_group grid = cg::this_grid();
    LAS unsigned char* ldsl = (LAS unsigned char*)lds;
    const int G = gridDim.x;
    const int wvs_ = __builtin_amdgcn_readfirstlane(threadIdx.x >> 6);
    const Params& p0 = pin;
    volatile LAS unsigned* bst = (volatile LAS unsigned*)(ldsl + (LDS_BYTES - 64));
    if (threadIdx.x < 2) bst[threadIdx.x] = 0u;
    __syncthreads();
    const XcdBarrier xbar = xcd_barrier_post((unsigned*)(pin.ws + WS_BAR), bst);
    for (int phi = p0.ph_lo; phi < p0.ph_hi; ++phi) {
        int ph = __builtin_amdgcn_readfirstlane(phi); asm volatile("" : "+s"(ph));
        int bx = blockIdx.x; asm volatile("" : "+s"(bx));
        const Params& p = p0;
        size_t zoff_ = 0; asm volatile("" : "+s"(zoff_));
        unsigned char* ws_ = p0.ws + zoff_;
        float* out_ = p0.out + zoff_;
        float* ctxres = (float*)(ws_ + WS_CTX);
        const float* mod = (const float*)(ws_ + WS_MOD);
        bf16_t* hb = (bf16_t*)(ws_ + WS_H);
        bf16_t* side = (bf16_t*)((unsigned char*)out_ + 64 * MiB);
        unsigned long long pt0 = 0; if (PROBE_MASK) pt0 = __builtin_amdgcn_s_memrealtime();
        if (ph == 0) { if (PH_MASK & 0x1000) { mod_phase(p, ws_, lds, wvs_); __syncthreads(); cvt_phase(p, ws_, 0, lds, wvs_); } }
        else if (ph == 25) { if (PH_MASK & 0x2000) final_phase(p, (const bf16_t*)(ws_ + WS_H), out_, wvs_); }
        else {
            const int l = (ph - 1) / 12, sp = (ph - 1) % 12;
            const int Mrows = (l == 0) ? MT : ML;
            const float* xl = (l == 0) ? p.x : out_; const float* xc = (l == 0) ? p.ctx : ctxres;
            switch ((PH_MASK >> sp) & 1 ? sp : 99) {
            case 99: break;
            case 0: if (l == 1) cvt_phase(p, ws_, 1, lds, wvs_); modulate_phase(p, ws_, l, 1, p.x, l == 0 ? nullptr : (const bf16_t*)out_, l == 0 ? (bf16_t*)out_ : nullptr, xc, MT, nullptr, l == 1 ? (const float*)(ws_ + WS_BOUT) : nullptr, 11, mod + (size_t)4 * 6144 + 5120, wvs_); break;
            case 1: { pg8::Gemm g{hb, (const bf16_t*)(ws_ + WS_WIN1), 1024, 1024, 1024, nullptr, nullptr, 0}; pg8::StaticOrder S; S.init(MT, 3328, G, bx);
                pg8::EpiP2 E{(bf16_t*)(ws_ + WS_PQ), side, (float*)(ws_ + WS_AB), (bf16_t*)(ws_ + WS_BOUT)};
                pg8::gemm_phase<pg8::EpiP2, pg8::StaticOrder>(ldsl, g, S, E, wvs_); break; }
            case 2: break;
            case 3: prep_phase(p, ws_, l, lds, wvs_); __syncthreads(); branch_phase(p, ws_, side, l, Mrows, lds, wvs_); break;
            case 4: scan_phase(p, ws_, lds, wvs_); break;
            case 5: ofinal_phase(p, ws_, l, Mrows, wvs_); break;
            case 6: break;
            case 7: { { pg8::Gemm g{(const bf16_t*)(ws_ + WS_BOUT), (const bf16_t*)(ws_ + WS_WBR), 1024, 1024, 512, hb, (const bf16_t*)(ws_ + WS_WG), 1024};
                  pg8::StaticOrder S; S.init(ML, 1024, G, bx); S.fused = 1;
                  pg8::EpiYG E{(bf16_t*)(ws_ + WS_R) + (size_t)bx * 65536, (bf16_t*)(ws_ + WS_R) + (size_t)(G + bx) * 65536, (bf16_t*)(ws_ + WS_PQ)};
                  pg8::gemm_phase<pg8::EpiYG, pg8::StaticOrder, true>(ldsl, g, S, E, wvs_); }
                if (l == 0) {
                  pg8::Gemm g{(const bf16_t*)(ws_ + WS_BOUT), (const bf16_t*)(ws_ + WS_WBR), 1024, 1024, 512, hb, (const bf16_t*)(ws_ + WS_WG), 1024}; pg8::CtxPairOrder S{G, (bx + 64) % G};
                  pg8::EpiYZ E{(bf16_t*)(ws_ + WS_R)};
                  pg8::gemm_phase<pg8::EpiYZ, pg8::CtxPairOrder, true>(ldsl, g, S, E, wvs_); }
                break; }
            case 8: { { pg8::Gemm g{(const bf16_t*)(ws_ + WS_PQ), (const bf16_t*)(ws_ + WS_WO3), 1024, 1024, 1024, nullptr, nullptr, 0}; pg8::StaticOrder S; S.init(ML, 1024, G, bx);
                  pg8::EpiRes E{(const bf16_t*)out_, (bf16_t*)out_, mod + (size_t)l * 5 * 6144 + 2048};
                  pg8::gemm_phase<pg8::EpiRes, pg8::StaticOrder>(ldsl, g, S, E, wvs_); }
                if (l == 0) {
                  pg8::Gemm g{(const bf16_t*)(ws_ + WS_R), (const bf16_t*)(ws_ + WS_WO3), 3072, 1024, 256, nullptr, nullptr, 0}; pg8::CtxOrder<4, 12, 4> S{G, (bx + 32) % G, 512, 512, 1 << 30, 0, 0, 0};
                  pg8::EpiPart E{(float*)(ws_ + WS_BOUT), 12};
                  pg8::gemm_phase<pg8::EpiPart, pg8::CtxOrder<4, 12, 4>>(ldsl, g, S, E, wvs_); }
                break; }
            case 9: modulate_phase(p, ws_, l, 2, p.x, (const bf16_t*)out_, nullptr, l == 0 ? p.ctx : ctxres, Mrows, l == 0 ? ctxres : nullptr, l == 0 ? (const float*)(ws_ + WS_BOUT) : nullptr, 12, mod + (size_t)4 * 6144 + 2048, wvs_); break;
            case 10: { pg8::Gemm g{hb, (const bf16_t*)(ws_ + WS_WGU), 1024, 1024, 1024, nullptr, nullptr, 0}; pg8::StaticOrder S; S.init(Mrows, 2 * DFF, G, bx);
                pg8::EpiSwi E{(bf16_t*)(ws_ + WS_R)};
                pg8::gemm_phase<pg8::EpiSwi, pg8::StaticOrder>(ldsl, g, S, E, wvs_); break; }
            case 11: { { pg8::Gemm g{(const bf16_t*)(ws_ + WS_R), (const bf16_t*)(ws_ + WS_WDN), DFF, DFF, DFF, nullptr, nullptr, 0}; pg8::StaticOrder S; S.init(ML, 1024, G, bx);
                  pg8::EpiRes E{(const bf16_t*)out_, l == 0 ? (bf16_t*)out_ : hb, mod + (size_t)l * 5 * 6144 + 5120};
                  pg8::gemm_phase<pg8::EpiRes, pg8::StaticOrder>(ldsl, g, S, E, wvs_); }
                if (l == 0) {
                  pg8::Gemm g{(const bf16_t*)(ws_ + WS_R), (const bf16_t*)(ws_ + WS_WDN), DFF, DFF, 256, nullptr, nullptr, 0}; pg8::CtxOrder<4, 11, 0> S{G, (bx + 48) % G, 512, 512, 1 << 30, 0, 0, 0};
                  pg8::EpiPart E{(float*)(ws_ + WS_BOUT), 11};
                  pg8::gemm_phase<pg8::EpiPart, pg8::CtxOrder<4, 11, 0>>(ldsl, g, S, E, wvs_); }
                break; }
            }
        }
        if (PROBE_MASK) { if ((PROBE_MASK >> ph) & 1u) { __syncthreads(); const unsigned long long pt1 = __builtin_amdgcn_s_memrealtime(); const unsigned long long tend = pt1 + (pt1 - pt0);
            while (__builtin_amdgcn_s_memrealtime() < tend) __builtin_amdgcn_s_sleep(4); } }
        if (phi + 1 < p0.ph_hi && ph != 19 && ph != 7 && ph != 3 && ph != 15) { if (phi == p0.ph_lo) grid.sync(); else { XcdBarrier xb2 = xbar; xb2.bar = (unsigned*)(ws_ + WS_BAR); xcd_barrier(xb2); } }
    }
}

extern "C" void kernel_launch(void* const* d_in, const int* in_sizes, int n_in, void* d_out, int out_size, void* d_ws, size_t ws_size, hipStream_t stream) {
    static int grid_blocks = 0;
    if (grid_blocks == 0) {
        if (n_in != 23 || out_size != ML * DM || ws_size < WS_END) { fprintf(stderr, "kernel_launch: unexpected shapes (n_in %d out %d ws %zu)\n", n_in, out_size, ws_size); grid_blocks = -1; return; }
        int dev = 0, cus = 0, per_cu = 0;
        hipGetDevice(&dev);
        hipDeviceGetAttribute(&cus, hipDeviceAttributeMultiprocessorCount, dev);
        if (hipFuncSetAttribute((const void*)fwd_megakernel, hipFuncAttributeMaxDynamicSharedMemorySize, LDS_BYTES) != hipSuccess) { fprintf(stderr, "kernel_launch: hipFuncSetAttribute failed\n"); grid_blocks = -1; return; }
        hipOccupancyMaxActiveBlocksPerMultiprocessor(&per_cu, (const void*)fwd_megakernel, 512, LDS_BYTES);
        if (per_cu < 1) { fprintf(stderr, "kernel_launch: occupancy query says %d blocks/CU\n", per_cu); grid_blocks = -1; return; }
        grid_blocks = cus * (per_cu > 1 ? 1 : per_cu);
    }
    if (grid_blocks < 0) return;
    Params p{};
    const float** pp = (const float**)&p;
    for (int i = 0; i < 23; ++i) pp[i] = (const float*)d_in[i];
    p.out = (float*)d_out; p.ws = (unsigned char*)d_ws; p.ph_lo = 0; p.ph_hi = N_PHASES;
    if (hipMemsetAsync((char*)d_ws + WS_BAR, 0, XCD_BAR_WORDS * 4, stream) != hipSuccess) { fprintf(stderr, "memset failed\n"); return; }
    void* args[] = {&p};
    hipError_t e = hipLaunchCooperativeKernel((const void*)fwd_megakernel, dim3(grid_blocks), dim3(512), args, LDS_BYTES, stream);
    if (e != hipSuccess) fprintf(stderr, "cooperative launch failed: %s (grid %d)\n", hipGetErrorString(e), grid_blocks);
}
```

```cpp
#include <hip/hip_runtime.h>
#include <hip/hip_cooperative_groups.h>
#include <cstdio>
#include <cstdint>
namespace cg = cooperative_groups;

#define LAS __attribute__((address_space(3)))
typedef unsigned short bf16_t;
typedef short bf16x8 __attribute__((ext_vector_type(8)));
typedef float f32x4 __attribute__((ext_vector_type(4)));
typedef unsigned u32x4 __attribute__((ext_vector_type(4)));
typedef unsigned u32x2 __attribute__((ext_vector_type(2)));

constexpr int DM = 1024, NB = 4, SEQ = 8192, CTXL = 256;
constexpr int ML = NB * SEQ;
constexpr int MC = NB * CTXL;
constexpr int MT = ML + MC;
constexpr int NIN = 6160, DFF = 2816;
constexpr int NCHUNK = MT / 64;
constexpr float EPS = 1e-6f;
constexpr int LDS_BYTES = 147456;

constexpr size_t MiB = 1u << 20;
constexpr size_t WS_MOD = 0;
constexpr size_t WS_BAR = 512 * 1024;
constexpr size_t WS_AB = 1 * MiB;
constexpr size_t WS_GC = 3 * MiB + 512 * 1024;
constexpr size_t WS_CTX = 5 * MiB;
constexpr size_t WS_WIN1 = 10 * MiB;
constexpr size_t WS_WG = WS_WIN1 + 3328 * 1024 * 2;
constexpr size_t WS_WBR = WS_WG + 3072 * 1024 * 2;
constexpr size_t WS_WO3 = WS_WBR + 3072 * 1024 * 2;
constexpr size_t WS_WGU = WS_WO3 + 1024 * 1024 * 2;
constexpr size_t WS_WDN = WS_WGU + 5632 * 1024 * 2;
constexpr size_t WS_H = 48 * MiB;
constexpr size_t WS_BOUT = 114 * MiB;
constexpr size_t WS_PQ = 180 * MiB;
constexpr size_t WS_R = 279 * MiB;
constexpr size_t SZ512 = (size_t)MT * 512 * 2;
constexpr size_t WS_QN = WS_R, WS_KT = WS_R + SZ512, WS_WB = WS_R + 2 * SZ512, WS_UB = WS_R + 4 * SZ512, WS_AQK = WS_R + 6 * SZ512;
constexpr size_t SZAQK = (size_t)NCHUNK * 4 * 64 * 64 * 2;
constexpr size_t WS_END = WS_AQK + 2 * SZAQK;
static_assert(WS_WDN + 1024 * 2816 * 2 <= WS_H, "weights");
static_assert(WS_END <= 512 * MiB, "ws");

struct Params {
    const float *x, *c, *ctx, *c_ctx, *w_ada, *b_ada, *norm1_g, *norm2_g, *w_in, *dn_conv_w, *dn_a_log, *dn_dt_bias, *dn_norm_g,
        *pool_w, *pool_scale, *sc_conv_w, *w_br_a, *w_br_b, *w_br_c, *w_o, *w_gu, *w_down, *final_norm_g;
    float* out; unsigned char* ws;
    int ph_lo, ph_hi;
};

typedef float f32x2_t __attribute__((ext_vector_type(2)));
typedef __bf16 bf16x2_t __attribute__((ext_vector_type(2)));
__device__ __forceinline__ unsigned pk2(float lo, float hi) { const f32x2_t v = {lo, hi}; const bf16x2_t b = __builtin_convertvector(v, bf16x2_t); return __builtin_bit_cast(unsigned, b); }
__device__ __forceinline__ unsigned f2bf(float f) { return pk2(f, 0.f) & 0xffffu; }
__device__ __forceinline__ float bflo(unsigned w) { return __uint_as_float(w << 16); }
__device__ __forceinline__ float bfhi(unsigned w) { return __uint_as_float(w & 0xffff0000u); }
__device__ __forceinline__ float bf2f(bf16_t h) { return __uint_as_float(((unsigned)h) << 16); }
__device__ __forceinline__ float siluf(float x) { return x * __builtin_amdgcn_rcpf(1.f + __expf(-x)); }
__device__ __forceinline__ float sigmf(float x) { return __builtin_amdgcn_rcpf(1.f + __expf(-x)); }
__device__ __forceinline__ void unpack8(const u32x4 v, float* f) {
    f[0] = bflo(v.x); f[1] = bfhi(v.x); f[2] = bflo(v.y); f[3] = bfhi(v.y); f[4] = bflo(v.z); f[5] = bfhi(v.z); f[6] = bflo(v.w); f[7] = bfhi(v.w);
}
__device__ __forceinline__ u32x4 pack8(const float* f) { u32x4 w; w.x = pk2(f[0], f[1]); w.y = pk2(f[2], f[3]); w.z = pk2(f[4], f[5]); w.w = pk2(f[6], f[7]); return w; }
__device__ __forceinline__ int opaque_tid(int wvs) { int t; asm volatile("v_mbcnt_lo_u32_b32 %0, -1, 0\n\tv_mbcnt_hi_u32_b32 %0, -1, %0" : "=v"(t)); return (wvs << 6) | t; }
__device__ __forceinline__ int bid_() { int b = blockIdx.x; asm volatile("" : "+s"(b)); return b; }
__device__ __forceinline__ int gdim_() { int g = gridDim.x; asm volatile("" : "+s"(g)); return g; }
__device__ __forceinline__ float lane_get(float v, int src_lane) { return __int_as_float(__builtin_amdgcn_ds_bpermute(src_lane << 2, __float_as_int(v))); }
__device__ __forceinline__ bool seq_first(int t) { return t < ML ? ((t & (SEQ - 1)) == 0) : (((t - ML) & (CTXL - 1)) == 0); }
__device__ __forceinline__ bool seq_last(int t) { return t < ML ? ((t & (SEQ - 1)) == SEQ - 1) : (((t - ML) & (CTXL - 1)) == CTXL - 1); }

namespace pg8 {
constexpr int BM = 256, BK = 64, HALF = 128, HTB = HALF * BK * 2, NXCD = 8, WGM = 8;
__device__ __forceinline__ int lds_byte(int r, int c) { const int st = (r >> 4) * 2 + (c >> 5), rr = r & 15, cc = c & 31, ob = rr * 64 + cc * 2; return st * 1024 + (ob ^ (((ob >> 9) & 1) << 5)); }
__device__ __forceinline__ void stage_rc(int b, int& R, int& C) { const int st = b / 1024, sb = b % 1024, swz = sb ^ (((sb >> 9) & 1) << 5); R = (st >> 1) * 16 + swz / 64; C = (st & 1) * 32 + (swz % 64) / 2; }
__device__ __forceinline__ int perm32(int rho) { const int n = rho >> 4, i = rho & 15; return 8 * (i >> 2) + 4 * n + (i & 3); }

struct Unit { int pm, pn, aoff, boff, ks, kind, nt; };
struct Gemm { const bf16_t* A; const bf16_t* Bt; int lda, ldb, K; const bf16_t* A2; const bf16_t* Bt2; int K2; };

struct StaticOrder {
    int nM, nN, nwg, G, c, a_thresh, a_bytes, triple, fused;
    __device__ void init(int M, int N, int G_, int c_) { nM = M / BM; nN = N / BM; nwg = nM * nN; G = G_; c = c_; a_thresh = 1 << 30; a_bytes = 0; triple = 0; fused = 0; }
    __device__ bool next(int i, Unit& u) const {
        const int sub = fused ? i % 6 : (triple ? i % 3 : 0), br = fused ? (sub >> 1) : sub; const long L = (long)(fused ? i / 6 : (triple ? i / 3 : i)) * G + c; if (L >= nwg) return false;
        int wgid = (int)L; { const int q = nwg / NXCD, r = nwg % NXCD, xcd = wgid % NXCD, off = wgid / NXCD; wgid = (xcd < r ? xcd * (q + 1) : r * (q + 1) + (xcd - r) * q) + off; }
        const int nig = WGM * nN, gid = wgid / nig, fm = gid * WGM, gsz = (nM - fm) < WGM ? (nM - fm) : WGM;
        u.pm = fm + ((wgid % nig) % gsz); u.pn = (wgid % nig) / gsz + 4 * br; u.aoff = (u.pn >= a_thresh) ? a_bytes : 0; u.boff = 0; u.ks = 0; u.kind = 0; u.nt = 0;
        if (fused) { u.kind = sub & 1; u.aoff = u.kind ? 0 : (br == 0 ? 0 : (br == 1 ? 1024 : 1536)); u.nt = u.kind ? 16 : (br == 0 ? 8 : 4); }
        return true;
    }
};

template <class Epi, class Sched, bool FUSED = false>
__device__ __forceinline__ void gemm_phase(LAS unsigned char* lds, const Gemm g, const Sched& S, const Epi& E, int wvs_) {
    const int tid = opaque_tid(wvs_), wid = __builtin_amdgcn_readfirstlane(tid >> 6), lane = tid & 63, wr = wid >> 2, wc = wid & 3, fr = lane & 15, fq = lane >> 4;
    const int K = g.K, nt_c = K / BK, lda = g.lda, ldb = g.ldb;
    unsigned voffA[2], voffB[2];
#pragma unroll
    for (int i = 0; i < 2; ++i) { int R, C; stage_rc(tid * 16 + i * 8192, R, C); const int Rb = (R & ~31) + perm32(R & 31);
        voffA[i] = (unsigned)(R * lda + C) * 2u; voffB[i] = (unsigned)(Rb * ldb + C) * 2u; }
    const size_t kstep = (size_t)(BK * 2);
    const size_t hstepA = (size_t)HALF * lda * 2, hstepB = (size_t)HALF * ldb * 2;
    const size_t tstepA = 2 * hstepA, tstepB = 2 * hstepB;
    const unsigned ldsw = (unsigned)wid * 1024u;
    const int aoff = lds_byte(wr * 64 + fr, fq * 8), boff = lds_byte(wc * 32 + fr, fq * 8);
#define PG8_SA(b, h) (((b) * 2 + (h)) * HTB)
#define PG8_SB(b, h) ((4 + (b) * 2 + (h)) * HTB)
#define PG8_STAGE(bufoff, gbase, voff) do { _Pragma("unroll") for (int _i = 0; _i < 2; ++_i) \
        __builtin_amdgcn_global_load_lds((const unsigned*)((const char*)(gbase) + (voff)[_i]), (LAS unsigned*)(lds + (bufoff) + ldsw + _i * 8192), 16, 0, 0); } while (0)
#define PG8_LDA(dst, b, h) do { _Pragma("unroll") for (int m = 0; m < 4; ++m) _Pragma("unroll") for (int k = 0; k < 2; ++k) dst[m][k] = *(const LAS bf16x8*)(lds + PG8_SA(b, h) + aoff + m * 2048 + k * 1024); } while (0)
#define PG8_LDB(dst, b, h) do { _Pragma("unroll") for (int n = 0; n < 2; ++n) _Pragma("unroll") for (int k = 0; k < 2; ++k) dst[n][k] = *(const LAS bf16x8*)(lds + PG8_SB(b, h) + boff + n * 2048 + k * 1024); } while (0)
#define PG8_MMA(ai, bj, At, Bt) do { __builtin_amdgcn_s_setprio(1); _Pragma("unroll") for (int m = 0; m < 4; ++m) _Pragma("unroll") for (int n = 0; n < 2; ++n) _Pragma("unroll") for (int k = 0; k < 2; ++k) \
        acc[ai][bj][m][n] = __builtin_amdgcn_mfma_f32_16x16x32_bf16(Bt[n][k], At[m][k], acc[ai][bj][m][n], 0, 0, 0); __builtin_amdgcn_s_setprio(0); } while (0)
#define PG8_WAIT_V(n) asm volatile("s_waitcnt vmcnt(" #n ")" ::: "memory")
#define PG8_WAIT_L(n) asm volatile("s_waitcnt lgkmcnt(" #n ")" ::: "memory")
#define PG8_BAR __builtin_amdgcn_s_barrier()
#define PG8_SCHED __builtin_amdgcn_sched_barrier(0)
    Unit cur, nxt; int ui = 0;
    if (!S.next(0, cur)) return;
    f32x4 acc[2][2][4][2];
#pragma unroll
    for (int a = 0; a < 2; ++a)
#pragma unroll
        for (int b = 0; b < 2; ++b)
#pragma unroll
            for (int m = 0; m < 4; ++m)
#pragma unroll
                for (int n = 0; n < 2; ++n) acc[a][b][m][n] = (f32x4){0.f, 0.f, 0.f, 0.f};
    bf16x8 At[4][2], B0[2][2], B1[2][2];
    const char* cA = (const char*)((FUSED && cur.kind) ? g.A2 : g.A) + (size_t)cur.pm * tstepA + cur.aoff; const char* cB = (const char*)((FUSED && cur.kind) ? g.Bt2 : g.Bt) + (size_t)cur.pn * tstepB + cur.boff;
    PG8_STAGE(PG8_SB(0, 0), cB, voffB); PG8_STAGE(PG8_SB(0, 1), cB + hstepB, voffB); PG8_STAGE(PG8_SA(0, 0), cA, voffA); PG8_STAGE(PG8_SA(0, 1), cA + hstepA, voffA);
    if (wr == 1) PG8_BAR;
    PG8_WAIT_V(2); PG8_BAR;
    PG8_STAGE(PG8_SB(1, 0), cB + kstep, voffB); PG8_STAGE(PG8_SA(1, 0), cA + kstep, voffA); PG8_STAGE(PG8_SB(1, 1), cB + hstepB + kstep, voffB);
    PG8_WAIT_V(6); PG8_BAR;
    for (;;) {
        const bool has_next = S.next(ui + 1, nxt);
        const char* nA = has_next ? (const char*)((FUSED && nxt.kind) ? g.A2 : g.A) + (size_t)nxt.pm * tstepA + nxt.aoff : cA; const char* nB = has_next ? (const char*)((FUSED && nxt.kind) ? g.Bt2 : g.Bt) + (size_t)nxt.pn * tstepB + nxt.boff : cB;
        const int nt = FUSED ? cur.nt : nt_c;
        for (int t = 0; t < nt; t += 2) {
            const bool last = (t == nt - 2);
            const char* a1 = cA + (size_t)(t + 1) * kstep;
            const char* a2 = last ? nA : cA + (size_t)(t + 2) * kstep; const char* b2 = last ? nB : cB + (size_t)(t + 2) * kstep;
            const char* a3 = a2 + kstep; const char* b3 = b2 + kstep;
            PG8_LDB(B0, 0, 0); PG8_LDB(B1, 0, 1); PG8_SCHED; PG8_LDA(At, 0, 0); PG8_STAGE(PG8_SA(1, 1), a1 + hstepA, voffA);
            PG8_WAIT_V(8); PG8_WAIT_L(0); PG8_BAR; PG8_MMA(0, 0, At, B0); PG8_MMA(0, 1, At, B1); PG8_BAR; PG8_SCHED;
            PG8_LDA(At, 0, 1); PG8_STAGE(PG8_SB(0, 0), b2, voffB); PG8_STAGE(PG8_SB(0, 1), b2 + hstepB, voffB); PG8_STAGE(PG8_SA(0, 0), a2, voffA);
            PG8_WAIT_V(8); PG8_WAIT_L(0); PG8_BAR; PG8_MMA(1, 0, At, B0); PG8_MMA(1, 1, At, B1); PG8_BAR; PG8_SCHED;
            PG8_LDB(B0, 1, 0); PG8_LDB(B1, 1, 1); PG8_SCHED; PG8_LDA(At, 1, 0); PG8_STAGE(PG8_SA(0, 1), a2 + hstepA, voffA);
            PG8_WAIT_V(8); PG8_WAIT_L(0); PG8_BAR; PG8_MMA(0, 0, At, B0); PG8_MMA(0, 1, At, B1); PG8_BAR; PG8_SCHED;
            PG8_LDA(At, 1, 1); PG8_STAGE(PG8_SB(1, 0), b3, voffB); PG8_STAGE(PG8_SB(1, 1), b3 + hstepB, voffB); PG8_STAGE(PG8_SA(1, 0), a3, voffA);
            PG8_WAIT_V(8); PG8_WAIT_L(0); PG8_BAR; PG8_MMA(1, 0, At, B0); PG8_MMA(1, 1, At, B1); PG8_BAR; PG8_SCHED;
        }
        if (wr == 0) PG8_BAR;
        { const int ln2 = opaque_tid(wvs_) & 63; const int fr2 = ln2 & 15, fq2 = ln2 >> 4;
          E(acc, cur, wr, wc, fr2, fq2); }
        if (!has_next) break;
#pragma unroll
        for (int a = 0; a < 2; ++a)
#pragma unroll
            for (int b = 0; b < 2; ++b)
#pragma unroll
                for (int m = 0; m < 4; ++m)
#pragma unroll
                    for (int n = 0; n < 2; ++n) acc[a][b][m][n] = (f32x4){0.f, 0.f, 0.f, 0.f};
        cur = nxt; cA = nA; cB = nB; ++ui;
        if (wr == 1) PG8_BAR;
    }
    PG8_WAIT_V(0);
    PG8_BAR;
#undef PG8_SA
#undef PG8_SB
#undef PG8_STAGE
#undef PG8_LDA
#undef PG8_LDB
#undef PG8_MMA
#undef PG8_WAIT_V
#undef PG8_WAIT_L
#undef PG8_BAR
#undef PG8_SCHED
}

typedef f32x4 Acc[2][2][4][2];

struct EpiP2 {
    bf16_t* pq; bf16_t* prest; float* ab; bf16_t* bout;
    __device__ __forceinline__ void operator()(const Acc& acc, const Unit& u, int wr, int wc, int fr, int fq) const {
        const int row0 = u.pm * BM + wr * 64 + fr, colb = u.pn * BM + wc * 32 + 8 * fq;
        if (u.pn == 9 || u.pn == 10) {
            const int cx = 256 + (u.pn - 9) * 128 + wc * 32 + 8 * fq;
#pragma unroll
            for (int ai = 0; ai < 2; ++ai)
#pragma unroll
                for (int m = 0; m < 4; ++m) { const f32x4 p0 = acc[ai][0][m][0] * acc[ai][1][m][0], p1 = acc[ai][0][m][1] * acc[ai][1][m][1];
                    u32x4 w; w.x = pk2(p0[0], p0[1]); w.y = pk2(p0[2], p0[3]); w.z = pk2(p1[0], p1[1]); w.w = pk2(p1[2], p1[3]);
                    *(u32x4*)(prest + (size_t)(row0 + ai * HALF + m * 16) * 768 + cx) = w; }
            return; }
#pragma unroll
        for (int ai = 0; ai < 2; ++ai)
#pragma unroll
            for (int m = 0; m < 4; ++m) { const size_t row = (size_t)(row0 + ai * HALF + m * 16);
#pragma unroll
                for (int bj = 0; bj < 2; ++bj) { const int col = colb + bj * HALF; const f32x4 v0 = acc[ai][bj][m][0], v1 = acc[ai][bj][m][1];
                    if (col >= 1536 && col < 2048) { u32x4 w; w.x = pk2(siluf(v0[0]), siluf(v0[1])); w.y = pk2(siluf(v0[2]), siluf(v0[3])); w.z = pk2(siluf(v1[0]), siluf(v1[1])); w.w = pk2(siluf(v1[2]), siluf(v1[3]));
                        *(u32x4*)(bout + row * 1024 + (col - 1536)) = w; }
                    else if (col < 3072) { u32x4 w; w.x = pk2(v0[0], v0[1]); w.y = pk2(v0[2], v0[3]); w.z = pk2(v1[0], v1[1]); w.w = pk2(v1[2], v1[3]);
                        if (col < 1536) *(u32x4*)(pq + row * 1536 + col) = w; else *(u32x4*)(prest + row * 768 + (col < 2304 ? col - 2048 : col - 2304)) = w; }
                    else if (col < 3088) { float* p = ab + row * 16 + (col - 3072); *(f32x4*)p = v0; *(f32x4*)(p + 4) = v1; } } }
    }
};
struct EpiY {
    bf16_t* O; int ldc;
    __device__ __forceinline__ void operator()(const Acc& acc, const Unit& u, int wr, int wc, int fr, int fq) const {
        const int row0 = u.pm * BM + wr * 64 + fr, colb = u.pn * BM + wc * 32 + 8 * fq;
#pragma unroll
        for (int ai = 0; ai < 2; ++ai)
#pragma unroll
            for (int m = 0; m < 4; ++m) { bf16_t* rowp = O + (size_t)(row0 + ai * HALF + m * 16) * ldc + colb;
#pragma unroll
                for (int bj = 0; bj < 2; ++bj) { const f32x4 v0 = acc[ai][bj][m][0], v1 = acc[ai][bj][m][1];
                    u32x4 w; w.x = pk2(v0[0], v0[1]); w.y = pk2(v0[2], v0[3]); w.z = pk2(v1[0], v1[1]); w.w = pk2(v1[2], v1[3]);
                    *(u32x4*)(rowp + bj * HALF) = w; } }
    }
};
struct EpiG {
    const bf16_t* Y; bf16_t* O;
    __device__ __forceinline__ void operator()(const Acc& acc, const Unit& u, int wr, int wc, int fr, int fq) const {
        const int row0 = u.pm * BM + wr * 64 + fr, colb = u.pn * BM + wc * 32 + 8 * fq, br = u.pn >> 2, colo = colb - br * 1024;
#pragma unroll
        for (int ai = 0; ai < 2; ++ai)
#pragma unroll
            for (int m = 0; m < 4; ++m) { const size_t row = (size_t)(row0 + ai * HALF + m * 16);
#pragma unroll
                for (int bj = 0; bj < 2; ++bj) { const f32x4 v0 = acc[ai][bj][m][0], v1 = acc[ai][bj][m][1];
                    const u32x4 y = *(const u32x4*)(Y + row * 3072 + colb + bj * HALF);
                    float f[8];
                    f[0] = sigmf(v0[0]) * bflo(y.x); f[1] = sigmf(v0[1]) * bfhi(y.x); f[2] = sigmf(v0[2]) * bflo(y.y); f[3] = sigmf(v0[3]) * bfhi(y.y);
                    f[4] = sigmf(v1[0]) * bflo(y.z); f[5] = sigmf(v1[1]) * bfhi(y.z); f[6] = sigmf(v1[2]) * bflo(y.w); f[7] = sigmf(v1[3]) * bfhi(y.w);
                    bf16_t* op = O + row * 1024 + colo + bj * HALF;
                    if (br > 0) { float o[8]; unpack8(*(const u32x4*)op, o);
#pragma unroll
                        for (int e = 0; e < 8; ++e) f[e] += o[e]; }
                    *(u32x4*)op = pack8(f); } }
    }
};
struct EpiYG {
    bf16_t* ring; bf16_t* O;
    __device__ __forceinline__ void operator()(const Acc& acc, const Unit& u, int wr, int wc, int fr, int fq) const {
        const int rl = wr * 64 + fr, cl = wc * 32 + 8 * fq;
        if (u.kind == 0) {
#pragma unroll
            for (int ai = 0; ai < 2; ++ai)
#pragma unroll
                for (int m = 0; m < 4; ++m)
#pragma unroll
                    for (int bj = 0; bj < 2; ++bj) { const f32x4 v0 = acc[ai][bj][m][0], v1 = acc[ai][bj][m][1];
                        u32x4 w; w.x = pk2(v0[0], v0[1]); w.y = pk2(v0[2], v0[3]); w.z = pk2(v1[0], v1[1]); w.w = pk2(v1[2], v1[3]);
                        *(u32x4*)(ring + (rl + ai * HALF + m * 16) * 256 + cl + bj * HALF) = w; }
        } else {
            const int row0 = u.pm * BM + rl, br = u.pn >> 2, colo = (u.pn & 3) * BM + cl;
#pragma unroll
            for (int ai = 0; ai < 2; ++ai)
#pragma unroll
                for (int m = 0; m < 4; ++m) { const size_t row = (size_t)(row0 + ai * HALF + m * 16);
#pragma unroll
                    for (int bj = 0; bj < 2; ++bj) { const f32x4 v0 = acc[ai][bj][m][0], v1 = acc[ai][bj][m][1];
                        const u32x4 y = *(const u32x4*)(ring + (rl + ai * HALF + m * 16) * 256 + cl + bj * HALF);
                        float f[8];
                        f[0] = sigmf(v0[0]) * bflo(y.x); f[1] = sigmf(v0[1]) * bfhi(y.x); f[2] = sigmf(v0[2]) * bflo(y.y); f[3] = sigmf(v0[3]) * bfhi(y.y);
                        f[4] = sigmf(v1[0]) * bflo(y.z); f[5] = sigmf(v1[1]) * bfhi(y.z); f[6] = sigmf(v1[2]) * bflo(y.w); f[7] = sigmf(v1[3]) * bfhi(y.w);
                        bf16_t* op = O + row * 1024 + colo + bj * HALF;
                        if (br > 0) { float o[8]; unpack8(*(const u32x4*)op, o);
#pragma unroll
                            for (int e = 0; e < 8; ++e) f[e] += o[e]; }
                        *(u32x4*)op = pack8(f); } }
        }
    }
};
struct EpiRes {
    const bf16_t* res_bf; bf16_t* out_bf; const float* gate;
    __device__ __forceinline__ void operator()(const Acc& acc, const Unit& u, int wr, int wc, int fr, int fq) const {
        const int row0 = u.pm * BM + wr * 64 + fr, colb = u.pn * BM + wc * 32 + 8 * fq;
        const int gr = (u.pm * BM) >> 13;
        f32x4 gv[2][2];
#pragma unroll
        for (int bj = 0; bj < 2; ++bj)
#pragma unroll
            for (int n = 0; n < 2; ++n) gv[bj][n] = *(const f32x4*)(gate + gr * 6144 + colb + bj * HALF + 4 * n);
#pragma unroll
        for (int ai = 0; ai < 2; ++ai)
#pragma unroll
            for (int m = 0; m < 4; ++m) { const size_t ro = (size_t)(row0 + ai * HALF + m * 16) * 1024 + colb;
#pragma unroll
                for (int bj = 0; bj < 2; ++bj) { const u32x4 rv = *(const u32x4*)(res_bf + ro + bj * HALF);
                    const f32x4 a0 = gv[bj][0] * acc[ai][bj][m][0], a1 = gv[bj][1] * acc[ai][bj][m][1];
                    u32x4 w; w.x = pk2(bflo(rv.x) + a0[0], bfhi(rv.x) + a0[1]); w.y = pk2(bflo(rv.y) + a0[2], bfhi(rv.y) + a0[3]);
                    w.z = pk2(bflo(rv.z) + a1[0], bfhi(rv.z) + a1[1]); w.w = pk2(bflo(rv.w) + a1[2], bfhi(rv.w) + a1[3]);
                    *(u32x4*)(out_bf + ro + bj * HALF) = w; } }
    }
};
struct EpiSwi {
    bf16_t* H;
    __device__ __forceinline__ void operator()(const Acc& acc, const Unit& u, int wr, int wc, int fr, int fq) const {
        const int row0 = u.pm * BM + wr * 64 + fr, colb = u.pn * HALF + wc * 32 + 8 * fq;
#pragma unroll
        for (int ai = 0; ai < 2; ++ai)
#pragma unroll
            for (int m = 0; m < 4; ++m) { bf16_t* rowp = H + (size_t)(row0 + ai * HALF + m * 16) * DFF + colb;
                const f32x4 g0 = acc[ai][0][m][0], g1 = acc[ai][0][m][1], u0 = acc[ai][1][m][0], u1 = acc[ai][1][m][1];
                u32x4 w;
                w.x = pk2(siluf(g0[0]) * u0[0], siluf(g0[1]) * u0[1]); w.y = pk2(siluf(g0[2]) * u0[2], siluf(g0[3]) * u0[3]);
                w.z = pk2(siluf(g1[0]) * u1[0], siluf(g1[1]) * u1[1]); w.w = pk2(siluf(g1[2]) * u1[2], siluf(g1[3]) * u1[3]);
                *(u32x4*)rowp = w; }
    }
};

template <int NN, int NSPLIT, int BMOD> struct CtxOrder {
    int G, c, a_step, b_step, a_thresh, a_bytes, pn_off, a_base;
    __device__ bool next(int i, Unit& u) const {
        const int L = i * G + c; if (L >= 4 * NN * NSPLIT) return false;
        const int ks = L % NSPLIT, t = L / NSPLIT; u.pn = t % NN + pn_off; u.pm = 128 + t / NN; u.ks = ks; u.kind = 0; u.nt = 0; u.aoff = a_base + ks * a_step + (u.pn >= a_thresh ? a_bytes : 0); u.boff = (BMOD ? (ks % BMOD) : ks) * b_step; return true;
    }
};
struct EpiZ {
    bf16_t* Z;
    __device__ __forceinline__ void operator()(const Acc& acc, const Unit& u, int wr, int wc, int fr, int fq) const {
        const int row0 = u.pm * BM + wr * 64 + fr, colb = u.pn * BM + wc * 32 + 8 * fq;
#pragma unroll
        for (int ai = 0; ai < 2; ++ai)
#pragma unroll
            for (int m = 0; m < 4; ++m) { bf16_t* rowp = Z + (size_t)(row0 + ai * HALF + m * 16) * 3072 + colb;
#pragma unroll
                for (int bj = 0; bj < 2; ++bj) { const f32x4 v0 = acc[ai][bj][m][0], v1 = acc[ai][bj][m][1];
                    const u32x4 y = *(const u32x4*)(rowp + bj * HALF);
                    u32x4 w;
                    w.x = pk2(sigmf(v0[0]) * bflo(y.x), sigmf(v0[1]) * bfhi(y.x)); w.y = pk2(sigmf(v0[2]) * bflo(y.y), sigmf(v0[3]) * bfhi(y.y));
                    w.z = pk2(sigmf(v1[0]) * bflo(y.z), sigmf(v1[1]) * bfhi(y.z)); w.w = pk2(sigmf(v1[2]) * bflo(y.w), sigmf(v1[3]) * bfhi(y.w));
                    *(u32x4*)(rowp + bj * HALF) = w; } }
    }
};
struct CtxPairOrder {
    int G, c;
    __device__ bool next(int i, Unit& u) const {
        const int t = (i >> 1) * G + c; if (t >= 48) return false;
        u.kind = i & 1; u.pn = t % 12; u.pm = 128 + t / 12; u.boff = 0; u.ks = 0;
        const int br = u.pn >> 2; u.aoff = u.kind ? 0 : (br == 0 ? 0 : (br == 1 ? 1024 : 1536)); u.nt = u.kind ? 16 : (br == 0 ? 8 : 4); return true;
    }
};
struct EpiYZ {
    bf16_t* Ycat;
    __device__ __forceinline__ void operator()(const Acc& acc, const Unit& u, int wr, int wc, int fr, int fq) const {
        if (u.kind == 0) { EpiY e{Ycat, 3072}; e(acc, u, wr, wc, fr, fq); } else { EpiZ e{Ycat}; e(acc, u, wr, wc, fr, fq); }
    }
};
struct EpiPart {
    float* part; int nsplit_unused;
    __device__ __forceinline__ void operator()(const Acc& acc, const Unit& u, int wr, int wc, int fr, int fq) const {
        const int row0 = (u.pm - 128) * BM + wr * 64 + fr, colb = u.pn * BM + wc * 32 + 8 * fq;
        float* base = part + (size_t)u.ks * (MC * 1024) + (size_t)row0 * 1024 + colb;
#pragma unroll
        for (int ai = 0; ai < 2; ++ai)
#pragma unroll
            for (int m = 0; m < 4; ++m) { float* ro = base + (size_t)(ai * HALF + m * 16) * 1024;
#pragma unroll
                for (int bj = 0; bj < 2; ++bj)
#pragma unroll
                    for (int n = 0; n < 2; ++n) *(f32x4*)(ro + bj * HALF + 4 * n) = acc[ai][bj][m][n]; }
    }
};
}

__device__ __forceinline__ const float* wsrc(const Params& p, int l, int buf, int n, int k) {
    switch (buf) {
    case 0: { int c;
        if (n < 2048) c = n; else if (n < 2304) c = n + 16;
        else if (n < 2816) { const int t = (n - 2304) >> 8, w = (n - 2304) & 255; c = w < 128 ? 2320 + t * 128 + w : 2832 + t * 128 + (w - 128); }
        else if (n < 3072) c = n - 240; else c = n < 3088 ? n - 1024 : -1;
        if (c < 0) return nullptr; return p.w_in + (size_t)l * 1024 * NIN + (size_t)k * NIN + c; }
    case 1: return p.w_in + (size_t)l * 1024 * NIN + (size_t)k * NIN + 3088 + n;
    case 2: { const int br = n >> 10, nn = n & 1023;
        if (br == 0) return p.w_br_a + (size_t)l * 512 * 1024 + (size_t)k * 1024 + nn;
        if (br == 1) return k < 256 ? p.w_br_b + (size_t)l * 256 * 1024 + (size_t)k * 1024 + nn : nullptr;
        return k < 256 ? p.w_br_c + (size_t)l * 256 * 1024 + (size_t)k * 1024 + nn : nullptr; }
    case 3: return p.w_o + (size_t)l * 1024 * 1024 + (size_t)k * 1024 + n;
    case 4: { const int t = n >> 8, w = n & 255; const int c = w < 128 ? t * 128 + w : DFF + t * 128 + (w - 128); return p.w_gu + (size_t)l * 1024 * 2 * DFF + (size_t)k * 2 * DFF + c; }
    default: return p.w_down + (size_t)l * DFF * 1024 + (size_t)k * 1024 + n;
    }
}
struct CvtTile { int buf, K, n0, k0, pitch; size_t off; };
__device__ __forceinline__ CvtTile cvt_decode(int item) {
    const int cumt[7] = {0, 832, 1600, 1984, 2240, 3648, 4352};
    const int Ks[6] = {1024, 1024, 512, 1024, 1024, 2816};
    const size_t offs[6] = {WS_WIN1, WS_WG, WS_WBR, WS_WO3, WS_WGU, WS_WDN};
    CvtTile t; t.buf = 0;
#pragma unroll
    for (int b = 1; b < 6; ++b) if (item >= cumt[b]) t.buf = b;
    t.K = 1024; int base = 0; t.off = WS_WIN1;
#pragma unroll
    for (int b = 0; b < 6; ++b) if (t.buf == b) { t.K = Ks[b]; base = cumt[b]; t.off = offs[b]; }
    const int it = item - base, nkt = t.K / 64; t.k0 = (it % nkt) * 64; t.n0 = (it / nkt) * 64; t.pitch = (t.buf == 2) ? 1024 : t.K; return t;
}
__device__ void cvt_phase(const Params& p, unsigned char* ws_, int l, unsigned char* sm, int wvs_) {
    float* tile = (float*)sm;
    const int tid = opaque_tid(wvs_);
    constexpr int NT_ALL = 4352;
    for (int item = bid_(); item < NT_ALL; item += 2 * gdim_()) {
        CvtTile T[2]; T[0] = cvt_decode(item); const bool has2 = item + gdim_() < NT_ALL; T[1] = cvt_decode(has2 ? item + gdim_() : item);
        f32x4 v[2][2];
#pragma unroll
        for (int q = 0; q < 2; ++q)
#pragma unroll
            for (int r = 0; r < 2; ++r) { const int f4i = tid + 512 * r, kk = f4i >> 4, n4 = (f4i & 15) * 4;
                const float* src = wsrc(p, l, T[q].buf, T[q].n0 + n4, T[q].k0 + kk); v[q][r] = src ? *(const f32x4*)src : (f32x4){0.f, 0.f, 0.f, 0.f}; }
#pragma unroll
        for (int q = 0; q < 2; ++q)
#pragma unroll
            for (int r = 0; r < 2; ++r) { const int f4i = tid + 512 * r, kk = f4i >> 4, n4 = (f4i & 15) * 4;
#pragma unroll
                for (int e = 0; e < 4; ++e) tile[q * 4160 + kk * 65 + n4 + e] = v[q][r][e]; }
        __syncthreads();
#pragma unroll
        for (int q = 0; q < 2; ++q) { if (q == 0 || has2) { const int nn = tid >> 3, kg = tid & 7; float f[8];
#pragma unroll
            for (int i = 0; i < 8; ++i) f[i] = tile[q * 4160 + (kg * 8 + i) * 65 + nn];
            *(u32x4*)((bf16_t*)(ws_ + T[q].off) + (size_t)(T[q].n0 + nn) * T[q].pitch + T[q].k0 + kg * 8) = pack8(f); } }
        __syncthreads();
    }
}

__device__ void mod_phase(const Params& p, unsigned char* ws_, unsigned char* sm, int wvs_) {
    float* scv = (float*)sm; float* red = scv + 5120; float* mod = (float*)(ws_ + WS_MOD);
    const int tid = opaque_tid(wvs_);
    for (int i = tid; i < 5120; i += 512) { const int r = i >> 10, k = i & 1023; const float v = r < 4 ? p.c[r * 1024 + k] : p.c_ctx[k]; scv[i] = siluf(v); }
    __syncthreads();
    for (int item = bid_(); item < 192; item += gdim_()) {
        const int l = item / 96, cb = item % 96, cn = tid & 63, kg = tid >> 6, n = cb * 64 + cn;
        const float* W = p.w_ada + (size_t)l * 1024 * 6144;
        float a0 = 0, a1 = 0, a2 = 0, a3 = 0, a4 = 0;
        for (int kk = 0; kk < 128; ++kk) { const int k = kg * 128 + kk; const float w = W[(size_t)k * 6144 + n];
            a0 += scv[k] * w; a1 += scv[1024 + k] * w; a2 += scv[2048 + k] * w; a3 += scv[3072 + k] * w; a4 += scv[4096 + k] * w; }
        red[(kg * 5 + 0) * 64 + cn] = a0; red[(kg * 5 + 1) * 64 + cn] = a1; red[(kg * 5 + 2) * 64 + cn] = a2; red[(kg * 5 + 3) * 64 + cn] = a3; red[(kg * 5 + 4) * 64 + cn] = a4;
        __syncthreads();
        if (tid < 320) { const int r = tid >> 6, c2 = tid & 63; float s = 0; for (int q = 0; q < 8; ++q) s += red[(q * 5 + r) * 64 + c2];
            mod[(size_t)(l * 5 + r) * 6144 + cb * 64 + c2] = s + p.b_ada[l * 6144 + cb * 64 + c2]; }
        __syncthreads();
    }
}

__device__ __forceinline__ const float* mod_rowptr(const float* src_lat, const float* src_ctx, int row) { return row < ML ? src_lat + (size_t)row * 1024 : src_ctx + (size_t)(row - ML) * 1024; }
__device__ void modulate_phase(const Params& p, unsigned char* ws_, int l, int which, const float* src_lat, const bf16_t* src_lat_bf, bf16_t* copy_lat_bf, const float* src_ctx, int nrows, float* copy_ctx, const float* part, int nsplit, const float* pgate, int wvs_) {
    const int tid = opaque_tid(wvs_), wave = tid >> 6, lane = tid & 63;
    const float* mod = (const float*)(ws_ + WS_MOD); bf16_t* hb = (bf16_t*)(ws_ + WS_H);
    const float* g = (which == 1 ? p.norm1_g : p.norm2_g) + l * 1024;
    const int rstride = gdim_() * 8;
    for (int row0 = bid_() * 8 + wave; row0 < nrows; row0 += 3 * rstride) {
        f32x4 vv[3][4];
#pragma unroll
        for (int k = 0; k < 3; ++k) { const int row = min(row0 + k * rstride, nrows - 1);
            if (src_lat_bf && row < ML) {
#pragma unroll
                for (int j = 0; j < 4; ++j) { const u32x2 w2 = *(const u32x2*)(src_lat_bf + (size_t)row * 1024 + j * 256 + lane * 4); vv[k][j] = (f32x4){bflo(w2.x), bfhi(w2.x), bflo(w2.y), bfhi(w2.y)}; } }
            else { const float* xr = mod_rowptr(src_lat, src_ctx, row);
#pragma unroll
                for (int j = 0; j < 4; ++j) vv[k][j] = *(const f32x4*)(xr + j * 256 + lane * 4); } }
#pragma unroll
        for (int k = 0; k < 3; ++k) { const int row = row0 + k * rstride; if (row < nrows) {
            const int mr = row < ML ? (row >> 13) : 4;
            const float* shift = mod + (size_t)(l * 5 + mr) * 6144 + (which == 1 ? 0 : 3072); const float* scale = shift + 1024;
            f32x4 v[4]; float ss = 0.f;
#pragma unroll
            for (int j = 0; j < 4; ++j) { v[j] = vv[k][j]; ss += v[j][0] * v[j][0] + v[j][1] * v[j][1] + v[j][2] * v[j][2] + v[j][3] * v[j][3]; }
            if (part && row >= ML) {
                ss = 0.f;
#pragma unroll
                for (int j = 0; j < 4; ++j) { const int col = j * 256 + lane * 4; f32x4 a4 = {0.f, 0.f, 0.f, 0.f};
                    for (int ks = 0; ks < nsplit; ++ks) a4 += *(const f32x4*)(part + (size_t)ks * (MC * 1024) + (size_t)(row - ML) * 1024 + col);
                    v[j] += *(const f32x4*)(pgate + col) * a4;
                    ss += v[j][0] * v[j][0] + v[j][1] * v[j][1] + v[j][2] * v[j][2] + v[j][3] * v[j][3]; } }
            if (copy_lat_bf && row < ML) {
#pragma unroll
                for (int j = 0; j < 4; ++j) { u32x2 w2; w2.x = pk2(v[j][0], v[j][1]); w2.y = pk2(v[j][2], v[j][3]); *(u32x2*)(copy_lat_bf + (size_t)row * 1024 + j * 256 + lane * 4) = w2; } }
            if (copy_ctx && row >= ML) {
#pragma unroll
                for (int j = 0; j < 4; ++j) *(f32x4*)(copy_ctx + (size_t)(row - ML) * 1024 + j * 256 + lane * 4) = v[j]; }
#pragma unroll
            for (int o = 32; o >= 1; o >>= 1) ss += lane_get(ss, lane ^ o);
            const float rstd = rsqrtf(ss * (1.f / 1024.f) + EPS);
#pragma unroll
            for (int j = 0; j < 4; ++j) { const int col = j * 256 + lane * 4;
                const f32x4 gg = *(const f32x4*)(g + col), sc = *(const f32x4*)(scale + col), sh = *(const f32x4*)(shift + col);
                float y[4];
#pragma unroll
                for (int e = 0; e < 4; ++e) y[e] = v[j][e] * rstd * gg[e] * (1.f + sc[e]) + sh[e];
                u32x2 w; w.x = pk2(y[0], y[1]); w.y = pk2(y[2], y[3]);
                *(u32x2*)(hb + (size_t)row * 1024 + col) = w; } } }
    }
}

__device__ void branch_phase(const Params& p, unsigned char* ws_, const bf16_t* prest, int l, int nrows, unsigned char* sm, int wvs_) {
    const int tid = opaque_tid(wvs_), wv = __builtin_amdgcn_readfirstlane(tid >> 6), lane = tid & 63, fr = lane & 15, fq = lane >> 4;
    sm += (tid >> 10);
    bf16_t* bout = (bf16_t*)(ws_ + WS_BOUT);
    { const int gd = gdim_(), bd = bid_(), nextra = (NCHUNK * 4) % gd;
      const int n = nrows * 32, stride = (gd - nextra) * 512; const float* cw = p.sc_conv_w + l * 768;
      for (int i0 = (bd >= nextra) ? (bd - nextra) * 512 + tid : n; i0 < n; i0 += stride * 4) {
          u32x4 v0[4], vb[4], vm[4], vp[4];
#pragma unroll
          for (int k = 0; k < 4; ++k) { const int idx = min(i0 + k * stride, n - 1), tok = idx >> 5, c = (idx & 31) * 8;
              const bf16_t* r0 = prest + (size_t)tok * 768; const bf16_t* rm = seq_first(tok) ? r0 : r0 - 768; const bf16_t* rp = seq_last(tok) ? r0 : r0 + 768;
              v0[k] = *(const u32x4*)(r0 + 256 + c); vb[k] = *(const u32x4*)(r0 + 512 + c); vm[k] = *(const u32x4*)(rm + 256 + c); vp[k] = *(const u32x4*)(rp + 256 + c); }
#pragma unroll
          for (int k = 0; k < 4; ++k) { const int idx = i0 + k * stride; if (idx < n) { const int tok = idx >> 5, c = (idx & 31) * 8; const bool fst = seq_first(tok), lst = seq_last(tok);
              float a0[8], b0[8], am[8], ap[8], y[8];
              unpack8(v0[k], a0); unpack8(vb[k], b0); unpack8(vm[k], am); unpack8(vp[k], ap);
#pragma unroll
              for (int e = 0; e < 8; ++e) y[e] = b0[e] * ((fst ? 0.f : am[e]) * cw[c + e] + a0[e] * cw[256 + c + e] + (lst ? 0.f : ap[e]) * cw[512 + c + e]);
              *(u32x4*)(bout + (size_t)tok * 1024 + 768 + c) = pack8(y); } } } }
    float* V = (float*)sm; bf16_t* Dm = (bf16_t*)(sm + 16640); bf16_t* WpT = (bf16_t*)(sm + 16640 + 9216);
    const int nitems = (nrows > ML) ? (512 + 16) * 4 : 512 * 4;
    for (int item = bid_(); item < nitems; item += gdim_()) {
        const int gi = item & 3, rb = item >> 2, w = 2 << gi, lo = w >> 1, hi = w - 1 - lo;
        { const int ch = tid >> 3, dd0 = (tid & 7) * 8; const float* wp = p.pool_w + (size_t)(l * 4 + gi) * 4096 + ch * 64 + dd0;
          const f32x4 w0 = *(const f32x4*)wp, w1 = *(const f32x4*)(wp + 4);
#pragma unroll
          for (int e = 0; e < 4; ++e) { WpT[(dd0 + e) * 72 + ch] = (bf16_t)f2bf(w0[e]); WpT[(dd0 + 4 + e) * 72 + ch] = (bf16_t)f2bf(w1[e]); } }
        const int c = tid >> 3, cg8 = tid & 7, ch0 = cg8 * 8, colb = gi * 64 + ch0;
        float own[8], acc[8], d[8]; int tokbase;
#pragma unroll
        for (int e = 0; e < 8; ++e) acc[e] = 0.f;
        if (rb < 512) {
            const int b = rb >> 7, r = rb & 127, r0 = max(r - lo, 0), r1 = min(r + hi, 127); tokbase = b * SEQ + r * 64;
            u32x4 vv[16];
#pragma unroll
            for (int k = 0; k < 16; ++k) { const int rr = min(r0 + k, r1); vv[k] = *(const u32x4*)(prest + (size_t)(b * SEQ + rr * 64 + c) * 768 + colb); }
            unpack8(*(const u32x4*)(prest + (size_t)(tokbase + c) * 768 + colb), own);
#pragma unroll
            for (int k = 0; k < 16; ++k) { if (r0 + k <= r1) { float f[8]; unpack8(vv[k], f);
#pragma unroll
                for (int e = 0; e < 8; ++e) acc[e] += f[e]; } }
#pragma unroll
            for (int e = 0; e < 8; ++e) V[c * 65 + ch0 + e] = acc[e];
            __syncthreads();
            const int c0 = max(c - lo, 0), c1 = min(c + hi, 63); const float inv = 1.f / (float)((r1 - r0 + 1) * (c1 - c0 + 1));
            float s8[8];
#pragma unroll
            for (int e = 0; e < 8; ++e) s8[e] = 0.f;
            for (int cc = c0; cc <= c1; ++cc) {
#pragma unroll
                for (int e = 0; e < 8; ++e) s8[e] += V[cc * 65 + ch0 + e]; }
#pragma unroll
            for (int e = 0; e < 8; ++e) d[e] = s8[e] * inv - own[e];
        } else {
            const int cb = rb - 512, b = cb >> 2, s0 = (cb & 3) * 64 + c, sa = max(s0 - lo, 0), sb = min(s0 + hi, CTXL - 1); tokbase = ML + cb * 64;
            u32x4 vv[16];
#pragma unroll
            for (int k = 0; k < 16; ++k) { const int s2 = min(sa + k, sb); vv[k] = *(const u32x4*)(prest + (size_t)(ML + b * CTXL + s2) * 768 + colb); }
            unpack8(*(const u32x4*)(prest + (size_t)(tokbase + c) * 768 + colb), own);
#pragma unroll
            for (int k = 0; k < 16; ++k) { if (sa + k <= sb) { float f[8]; unpack8(vv[k], f);
#pragma unroll
                for (int e = 0; e < 8; ++e) acc[e] += f[e]; } }
            const float inv = 1.f / (float)(sb - sa + 1);
#pragma unroll
            for (int e = 0; e < 8; ++e) d[e] = acc[e] * inv - own[e];
            __syncthreads();
        }
        *(u32x4*)(Dm + c * 72 + ch0) = pack8(d);
        __syncthreads();
        { const int mt = wv & 3; const float* ps = p.pool_scale + l * 256 + gi * 64;
          const bf16x8 d0 = *(const bf16x8*)(Dm + (mt * 16 + fr) * 72 + fq * 8), d1 = *(const bf16x8*)(Dm + (mt * 16 + fr) * 72 + 32 + fq * 8);
#pragma unroll
          for (int q = 0; q < 2; ++q) { const int nt = (wv >> 2) * 2 + q; f32x4 o = {0.f, 0.f, 0.f, 0.f};
              o = __builtin_amdgcn_mfma_f32_16x16x32_bf16(*(const bf16x8*)(WpT + (nt * 16 + fr) * 72 + fq * 8), d0, o, 0, 0, 0);
              o = __builtin_amdgcn_mfma_f32_16x16x32_bf16(*(const bf16x8*)(WpT + (nt * 16 + fr) * 72 + 32 + fq * 8), d1, o, 0, 0, 0);
              const f32x4 sc = *(const f32x4*)(ps + nt * 16 + fq * 4);
              u32x2 wo; wo.x = pk2(o[0] * sc[0], o[1] * sc[1]); wo.y = pk2(o[2] * sc[2], o[3] * sc[3]);
              *(u32x2*)(bout + (size_t)(tokbase + mt * 16 + fr) * 1024 + 512 + gi * 64 + nt * 16 + fq * 4) = wo; } }
        __syncthreads();
    }
}

__device__ void prep_phase(const Params& p, unsigned char* ws_, int l, unsigned char* sm, int wvs_) {
    constexpr int OFF_Q = 0, OFF_K = 17408, OFF_VT = 36864, OFF_KT = 55296, OFF_A = 73728, OFF_G = 106496, OFF_TF = 108544;
    const int tid0_ = opaque_tid(wvs_); sm += (tid0_ >> 10);
    bf16_t* qS = (bf16_t*)(sm + OFF_Q); bf16_t* kS = (bf16_t*)(sm + OFF_K); bf16_t* TS = (bf16_t*)sm;
    bf16_t* vT = (bf16_t*)(sm + OFF_VT); bf16_t* kT = (bf16_t*)(sm + OFF_KT);
    float* Lm = (float*)(sm + OFF_A); float* Tm = (float*)(sm + OFF_TF); float* Xs = (float*)sm; float* gS = (float*)(sm + OFF_G); float* betaS = gS + 128; float* gcS = gS + 256;
    const int tid = opaque_tid(wvs_), wv = __builtin_amdgcn_readfirstlane(tid >> 6), lane = tid & 63, fr = lane & 15, fq = lane >> 4;
    const bf16_t* pq = (const bf16_t*)(ws_ + WS_PQ); const float* ab = (const float*)(ws_ + WS_AB);
    bf16_t* qn = (bf16_t*)(ws_ + WS_QN); bf16_t* kTg = (bf16_t*)(ws_ + WS_KT);
    float* gcg = (float*)(ws_ + WS_GC);
    const float* cw = p.dn_conv_w + (size_t)l * 3 * 1536;
    for (int item = bid_(); item < NCHUNK * 4; item += gdim_()) {
        const int itr = NCHUNK * 4 - 1 - item, g = itr >> 2, h = itr & 3, t0 = g * 64;
        if (tid < 128) { const int d = tid >> 6, i = tid & 63; const float a = ab[(size_t)(t0 + i) * 16 + d * 4 + h], bb = ab[(size_t)(t0 + i) * 16 + 8 + d * 4 + h];
            const float z = a + p.dn_dt_bias[l * 8 + d * 4 + h]; const float sp = fmaxf(z, 0.f) + log1pf(__expf(-fabsf(z)));
            float x = -__expf(p.dn_a_log[l * 8 + d * 4 + h]) * sp; betaS[d * 64 + i] = sigmf(bb);
#pragma unroll
            for (int off = 1; off < 64; off <<= 1) { const float up = lane_get(x, (i - off) & 63), dn = lane_get(x, (i + off) & 63);
                if (d == 0) { if (i >= off) x += up; } else { if (i + off < 64) x += dn; } }
            gcS[d * 64 + i] = x; gcg[((size_t)d * MT + t0 + i) * 4 + h] = x; }
        { const int i = tid >> 3, cg8 = tid & 7, t = t0 + i; const bool fst = seq_first(t), lst = seq_last(t);
#pragma unroll
          for (int part = 0; part < 3; ++part) {
              const int col = part * 512 + h * 128 + cg8 * 16; const bf16_t* r0 = pq + (size_t)t * 1536 + col;
              float x0[16], xm[16], xp[16], v[16];
              unpack8(*(const u32x4*)r0, x0); unpack8(*(const u32x4*)(r0 + 8), x0 + 8);
              if (!fst) { unpack8(*(const u32x4*)(r0 - 1536), xm); unpack8(*(const u32x4*)(r0 - 1536 + 8), xm + 8); }
              if (!lst) { unpack8(*(const u32x4*)(r0 + 1536), xp); unpack8(*(const u32x4*)(r0 + 1536 + 8), xp + 8); }
              float ss = 0.f;
#pragma unroll
              for (int e = 0; e < 16; ++e) { const float a = (fst ? 0.f : xm[e]) * cw[col + e] + x0[e] * cw[1536 + col + e] + (lst ? 0.f : xp[e]) * cw[3072 + col + e];
                  v[e] = siluf(a); ss += v[e] * v[e]; }
              if (part < 2) { ss += lane_get(ss, lane ^ 1); ss += lane_get(ss, lane ^ 2); ss += lane_get(ss, lane ^ 4);
                  const float rn = rsqrtf(ss + EPS) * (part == 0 ? 0.08838834764831845f : 1.f);
#pragma unroll
                  for (int e = 0; e < 16; ++e) v[e] *= rn; }
              if (part == 0) { const u32x4 w0 = pack8(v), w1 = pack8(v + 8);
                  *(u32x4*)(qS + i * 136 + cg8 * 16) = w0; *(u32x4*)(qS + i * 136 + cg8 * 16 + 8) = w1;
                  *(u32x4*)(qn + (size_t)t * 512 + h * 128 + cg8 * 16) = w0; *(u32x4*)(qn + (size_t)t * 512 + h * 128 + cg8 * 16 + 8) = w1; }
              else if (part == 1) { *(u32x4*)(kS + i * 136 + cg8 * 16) = pack8(v); *(u32x4*)(kS + i * 136 + cg8 * 16 + 8) = pack8(v + 8);
#pragma unroll
                  for (int e = 0; e < 16; ++e) kT[(cg8 * 16 + e) * 72 + i] = (bf16_t)f2bf(v[e]); }
              else {
#pragma unroll
                  for (int e = 0; e < 16; ++e) vT[(cg8 * 16 + e) * 72 + i] = (bf16_t)f2bf(v[e]); }
          } }
        __syncthreads();
        { const int j = tid >> 2, part = tid & 3; bf16_t* dst = kTg + ((size_t)(g * 4 + h) * 128 + j) * 64 + part * 16;
          *(u32x4*)dst = *(const u32x4*)(kT + j * 72 + part * 16); *(u32x4*)(dst + 8) = *(const u32x4*)(kT + j * 72 + part * 16 + 8); }
        { const int mt = wv & 3; const bf16_t* XS = (wv < 4) ? qS : kS; const int i = mt * 16 + fr;
          bf16x8 af[4];
#pragma unroll
          for (int ks = 0; ks < 4; ++ks) af[ks] = *(const bf16x8*)(XS + (mt * 16 + fr) * 136 + ks * 32 + fq * 8);
          const float gi0 = gcS[i], gi1 = gcS[64 + i], bi0 = betaS[i], bi1 = betaS[64 + i];
#pragma unroll
          for (int nt = 0; nt < 4; ++nt) { f32x4 acc = {0.f, 0.f, 0.f, 0.f};
#pragma unroll
              for (int ks = 0; ks < 4; ++ks) { const bf16x8 bfr = *(const bf16x8*)(kS + (nt * 16 + fr) * 136 + ks * 32 + fq * 8);
                  acc = __builtin_amdgcn_mfma_f32_16x16x32_bf16(bfr, af[ks], acc, 0, 0, 0); }
              const int jb = nt * 16 + fq * 4;
#pragma unroll
              for (int d = 0; d < 2; ++d) { float v[4];
#pragma unroll
                  for (int j = 0; j < 4; ++j) { const int jj = jb + j; const float e = __expf(fminf((d ? gi1 : gi0) - gcS[d * 64 + jj], 0.f));
                      if (wv < 4) { const bool ok = d == 0 ? (i >= jj) : (i <= jj); v[j] = ok ? acc[j] * e : 0.f; }
                      else { const bool ok = d == 0 ? (i > jj) : (i < jj); v[j] = ok ? (d ? bi1 : bi0) * acc[j] * e : 0.f; } }
                  if (wv < 4) { u32x2 w; w.x = pk2(v[0], v[1]); w.y = pk2(v[2], v[3]);
                      *(u32x2*)((bf16_t*)(ws_ + WS_AQK + d * SZAQK) + ((size_t)(g * 4 + h) * 64 + i) * 64 + jb) = w; }
                  else { const int md = d ? 63 : 0;
#pragma unroll
                      for (int j = 0; j < 4; ++j) Lm[d * 4096 + (i ^ md) * 64 + ((jb + j) ^ md)] = v[j]; } } } }
        __syncthreads();
        if (tid < 128) { const int d = tid >> 6, blk = (tid >> 4) & 3, col = tid & 15; const float* Lb = Lm + d * 4096 + (blk * 16) * 64 + blk * 16; float tc[16];
#pragma unroll
            for (int r = 0; r < 16; ++r) { float s = (r == col) ? 1.f : 0.f;
#pragma unroll
                for (int j = 0; j < r; ++j) s -= Lb[r * 64 + j] * tc[j];
                tc[r] = s; }
            float* Tb = Tm + d * 4096 + (blk * 16) * 64 + blk * 16 + col;
#pragma unroll
            for (int r = 0; r < 16; ++r) Tb[r * 64] = tc[r]; }
        __syncthreads();
#pragma unroll
        for (int dist = 1; dist <= 3; ++dist) {
            const int nper = 4 - dist; const bool act = wv < 2 * nper;
            const int d = wv / nper, R = dist + wv % nper, C = R - dist;
            const float* Ld = Lm + d * 4096; float* Td = Tm + d * 4096;
            if (act) { f32x4 X = {0.f, 0.f, 0.f, 0.f};
                for (int K = C; K < R; ++K) {
#pragma unroll
                    for (int kk = 0; kk < 4; ++kk) X = __builtin_amdgcn_mfma_f32_16x16x4f32(Ld[(R * 16 + fr) * 64 + K * 16 + kk * 4 + fq], Td[(K * 16 + kk * 4 + fq) * 64 + C * 16 + fr], X, 0, 0, 0); }
#pragma unroll
                for (int j = 0; j < 4; ++j) Xs[wv * 256 + (fq * 4 + j) * 16 + fr] = X[j]; }
            __syncthreads();
            if (act) { f32x4 Y = {0.f, 0.f, 0.f, 0.f};
#pragma unroll
                for (int kk = 0; kk < 4; ++kk) Y = __builtin_amdgcn_mfma_f32_16x16x4f32(Td[(R * 16 + fr) * 64 + R * 16 + kk * 4 + fq], Xs[wv * 256 + (kk * 4 + fq) * 16 + fr], Y, 0, 0, 0);
#pragma unroll
                for (int j = 0; j < 4; ++j) Td[(R * 16 + fq * 4 + j) * 64 + C * 16 + fr] = -Y[j]; }
            __syncthreads();
        }
        for (int idx = tid; idx < 8192; idx += 512) { const int d = idx >> 12, ip = (idx >> 6) & 63, cp = idx & 63, md = d ? 63 : 0, i = ip ^ md, c = cp ^ md;
            const float tv = ((cp >> 4) > (ip >> 4)) ? 0.f : Tm[d * 4096 + ip * 64 + cp]; const float bc = betaS[d * 64 + c];
            TS[(d * 2) * 4608 + i * 72 + c] = (bf16_t)f2bf(tv * bc); TS[(d * 2 + 1) * 4608 + i * 72 + c] = (bf16_t)f2bf(tv * bc * __expf(gcS[d * 64 + c])); }
        __syncthreads();
        { const int d = wv >> 2, which = (wv >> 1) & 1; const bf16_t* Tm2 = TS + (d * 2 + which) * 4608; const bf16_t* XT = which ? kT : vT;
          bf16_t* dst = (bf16_t*)(ws_ + (which ? WS_WB : WS_UB) + d * SZ512);
#pragma unroll
          for (int mi = 0; mi < 2; ++mi) { const int mt = (wv & 1) * 2 + mi;
              const bf16x8 a0 = *(const bf16x8*)(Tm2 + (mt * 16 + fr) * 72 + fq * 8), a1 = *(const bf16x8*)(Tm2 + (mt * 16 + fr) * 72 + 32 + fq * 8);
              bf16_t* drow = dst + (size_t)(t0 + mt * 16 + fr) * 512 + h * 128 + fq * 4;
#pragma unroll
              for (int nt = 0; nt < 8; ++nt) { f32x4 acc = {0.f, 0.f, 0.f, 0.f};
                  acc = __builtin_amdgcn_mfma_f32_16x16x32_bf16(*(const bf16x8*)(XT + (nt * 16 + fr) * 72 + fq * 8), a0, acc, 0, 0, 0);
                  acc = __builtin_amdgcn_mfma_f32_16x16x32_bf16(*(const bf16x8*)(XT + (nt * 16 + fr) * 72 + 32 + fq * 8), a1, acc, 0, 0, 0);
                  u32x2 w; w.x = pk2(acc[0], acc[1]); w.y = pk2(acc[2], acc[3]);
                  *(u32x2*)(drow + nt * 16) = w; } } }
        __syncthreads();
    }
}

namespace scn {
constexpr int ST_W = 0, ST_Q = 17408, ST_KT = 34816, ST_AQK = 53248, ST_U = 62464, ST_GC = 64512, ST_SIZE = 64768;
constexpr int OFF_ST = 2 * ST_SIZE, OFF_VN = OFF_ST + 4352, OFF_VS = OFF_VN + 2304;
struct Regs { u32x4 w0, w1, q0, q1, k0, k1, a, u; float g; };
struct Ptrs { const char *wb, *ub, *qn, *kTg, *aq, *gcg; bf16_t* ob; unsigned vo_w, vo_a, vo_k, vo_u, vo_g, lo_w, lo_a, lo_k, lo_u, lo_g; };
__device__ __forceinline__ void setup(Ptrs& P, int h, int sl, int tid) {
    { const int i = tid >> 3, pt = tid & 7; P.vo_w = (unsigned)((i * 512 + h * 128 + pt * 16) * 2); P.vo_a = (unsigned)(((h * 64 + i) * 64 + pt * 8) * 2);
      P.lo_w = (unsigned)((i * 136 + pt * 16) * 2); P.lo_a = (unsigned)(ST_AQK + (i * 72 + pt * 8) * 2); }
    { const int j = tid >> 2, pt = tid & 3; P.vo_k = (unsigned)(((h * 128 + j) * 64 + pt * 16) * 2); P.lo_k = (unsigned)(ST_KT + (j * 72 + pt * 16) * 2); }
    P.vo_u = (unsigned)((((tid >> 1) & 63) * 512 + h * 128 + sl * 16 + (tid & 1) * 8) * 2); P.lo_u = (unsigned)(ST_U + (((tid >> 1) & 63) * 16 + (tid & 1) * 8) * 2);
    P.vo_g = (unsigned)(((tid & 63) * 4 + h) * 4); P.lo_g = (unsigned)(ST_GC + (tid & 63) * 4);
}
__device__ __forceinline__ void load1(Regs& r, const Ptrs& P, int g) {
    const size_t o512 = (size_t)g * (64 * 512 * 2);
    const char* pw = P.wb + o512 + P.vo_w; const char* pq = P.qn + o512 + P.vo_w;
    r.w0 = *(const u32x4*)pw; r.w1 = *(const u32x4*)(pw + 16); r.q0 = *(const u32x4*)pq;
}
__device__ __forceinline__ void load2(Regs& r, const Ptrs& P, int g) {
    const size_t o512 = (size_t)g * (64 * 512 * 2), okt = (size_t)g * (4 * 128 * 64 * 2);
    r.q1 = *(const u32x4*)(P.qn + o512 + P.vo_w + 16);
    const char* pk = P.kTg + okt + P.vo_k; r.k0 = *(const u32x4*)pk; r.k1 = *(const u32x4*)(pk + 16);
}
__device__ __forceinline__ void load3(Regs& r, const Ptrs& P, int g) {
    const size_t o512 = (size_t)g * (64 * 512 * 2), oaq = (size_t)g * (4 * 64 * 64 * 2), ogc = (size_t)g * (64 * 4 * 4);
    r.a = *(const u32x4*)(P.aq + oaq + P.vo_a);
    r.u = *(const u32x4*)(P.ub + o512 + P.vo_u);
    r.g = *(const float*)(P.gcg + ogc + P.vo_g);
}
__device__ __forceinline__ void load(Regs& r, const Ptrs& P, int g, int tid) { load1(r, P, g); load2(r, P, g); load3(r, P, g); }
__device__ __forceinline__ void store(const Regs& r, const Ptrs& P, unsigned char* b, int tid) {
    *(u32x4*)(b + ST_W + P.lo_w) = r.w0; *(u32x4*)(b + ST_W + P.lo_w + 16) = r.w1;
    *(u32x4*)(b + ST_Q + P.lo_w) = r.q0; *(u32x4*)(b + ST_Q + P.lo_w + 16) = r.q1;
    *(u32x4*)(b + P.lo_a) = r.a;
    *(u32x4*)(b + P.lo_k) = r.k0; *(u32x4*)(b + P.lo_k + 16) = r.k1;
    if (tid < 128) *(u32x4*)(b + P.lo_u) = r.u;
    if (tid < 64) *(float*)(b + P.lo_g) = r.g;
}
__device__ __forceinline__ void step(unsigned char* sm, const unsigned char* bs, f32x4& accS, const Ptrs& P, int g, int h, int sl, int d, int wv, int fr, int fq, Regs& rl, int gld) {
    bf16_t* StS = (bf16_t*)(sm + OFF_ST); bf16_t* vnT = (bf16_t*)(sm + OFF_VN); bf16_t* vsT = (bf16_t*)(sm + OFF_VS);
    const bf16_t* wS = (const bf16_t*)(bs + ST_W); const bf16_t* qS = (const bf16_t*)(bs + ST_Q); const bf16_t* kTS = (const bf16_t*)(bs + ST_KT);
    const bf16_t* aS = (const bf16_t*)(bs + ST_AQK); const bf16_t* uS = (const bf16_t*)(bs + ST_U); const float* gcS = (const float*)(bs + ST_GC);
    const int t0 = g * 64, mt = wv & 3;
    const float gl = gcS[d ? 0 : 63];
    load1(rl, P, gld);
    f32x4 acc1 = {0.f, 0.f, 0.f, 0.f};
    if (wv < 4) {
#pragma unroll
        for (int ks = 0; ks < 4; ++ks) acc1 = __builtin_amdgcn_mfma_f32_16x16x32_bf16(*(const bf16x8*)(wS + (mt * 16 + fr) * 136 + ks * 32 + fq * 8),
                                                                                       *(const bf16x8*)(StS + fr * 136 + ks * 32 + fq * 8), acc1, 0, 0, 0);
        float vn[4], vs[4];
#pragma unroll
        for (int j = 0; j < 4; ++j) { const int i = mt * 16 + fq * 4 + j; vn[j] = bf2f(uS[i * 16 + fr]) - acc1[j]; vs[j] = vn[j] * __expf(gl - gcS[i]); }
        u32x2 w1, w2; w1.x = pk2(vn[0], vn[1]); w1.y = pk2(vn[2], vn[3]); w2.x = pk2(vs[0], vs[1]); w2.y = pk2(vs[2], vs[3]);
        *(u32x2*)(vnT + fr * 72 + mt * 16 + fq * 4) = w1; *(u32x2*)(vsT + fr * 72 + mt * 16 + fq * 4) = w2;
    } else {
#pragma unroll
        for (int ks = 0; ks < 4; ++ks) acc1 = __builtin_amdgcn_mfma_f32_16x16x32_bf16(*(const bf16x8*)(StS + fr * 136 + ks * 32 + fq * 8),
                                                                                       *(const bf16x8*)(qS + (mt * 16 + fr) * 136 + ks * 32 + fq * 8), acc1, 0, 0, 0);
    }
    bf16x8 ka[2], aa[2];
#pragma unroll
    for (int ks = 0; ks < 2; ++ks) { ka[ks] = *(const bf16x8*)(kTS + (wv * 16 + fr) * 72 + ks * 32 + fq * 8); aa[ks] = *(const bf16x8*)(aS + (mt * 16 + fr) * 72 + ks * 32 + fq * 8); }
    const float egi = __expf(gcS[mt * 16 + fr]), egl = __expf(gl);
    __syncthreads();
    load2(rl, P, gld);
    if (wv >= 4) { f32x4 acc3 = {0.f, 0.f, 0.f, 0.f};
#pragma unroll
        for (int ks = 0; ks < 2; ++ks) acc3 = __builtin_amdgcn_mfma_f32_16x16x32_bf16(*(const bf16x8*)(vnT + fr * 72 + ks * 32 + fq * 8), aa[ks], acc3, 0, 0, 0);
        const int i = mt * 16 + fr;
        u32x2 w; w.x = pk2(egi * acc1[0] + acc3[0], egi * acc1[1] + acc3[1]); w.y = pk2(egi * acc1[2] + acc3[2], egi * acc1[3] + acc3[3]);
        *(u32x2*)(P.ob + (size_t)(t0 + i) * 512 + h * 128 + sl * 16 + fq * 4) = w; }
    { f32x4 accn = {0.f, 0.f, 0.f, 0.f};
#pragma unroll
      for (int ks = 0; ks < 2; ++ks) accn = __builtin_amdgcn_mfma_f32_16x16x32_bf16(ka[ks], *(const bf16x8*)(vsT + fr * 72 + ks * 32 + fq * 8), accn, 0, 0, 0);
#pragma unroll
      for (int j = 0; j < 4; ++j) accS[j] = accS[j] * egl + accn[j];
      u32x2 w; w.x = pk2(accS[0], accS[1]); w.y = pk2(accS[2], accS[3]);
      *(u32x2*)(StS + fr * 136 + wv * 16 + fq * 4) = w; }
    load3(rl, P, gld);
}
}

__device__ void scan_phase(const Params& p, unsigned char* ws_, unsigned char* sm, int wvs_) {
    using namespace scn;
    const int tid = opaque_tid(wvs_), wv = __builtin_amdgcn_readfirstlane(tid >> 6), lane = tid & 63, fr = lane & 15, fq = lane >> 4;
    sm += (tid >> 10);
    bf16_t* StS = (bf16_t*)(sm + OFF_ST);
    for (int wu = bid_(); wu < 256; wu += gdim_()) {
        const int xcd = wu & 7, idx = wu >> 3, chain = xcd * 4 + (idx >> 3), sl = idx & 7, b = chain >> 3, h = (chain >> 1) & 3, d = chain & 1;
        Ptrs P; P.wb = (const char*)(ws_ + WS_WB + d * SZ512); P.ub = (const char*)(ws_ + WS_UB + d * SZ512);
        P.qn = (const char*)(ws_ + WS_QN); P.kTg = (const char*)(ws_ + WS_KT);
        P.aq = (const char*)(ws_ + WS_AQK + d * SZAQK); P.gcg = (const char*)(ws_ + WS_GC) + (size_t)d * MT * 16;
        P.ob = (bf16_t*)(ws_ + WS_PQ + d * SZ512); setup(P, h, sl, tid);
        f32x4 accS = {0.f, 0.f, 0.f, 0.f};
        for (int i = tid; i < 16 * 136; i += 512) StS[i] = 0;
#define SCAN_CHUNK(n_) ((n_) < 4 ? 512 + b * 4 + (d ? 3 - (n_) : (n_)) : b * 128 + (d ? 127 - ((n_) - 4) : ((n_) - 4)))
        Regs rA, rB; rA.u = (u32x4){0u, 0u, 0u, 0u}; rB.u = rA.u; rA.g = 0.f; rB.g = 0.f;
        { const int g0 = SCAN_CHUNK(0); load(rA, P, g0, tid); store(rA, P, sm, tid); }
        { const int g1 = SCAN_CHUNK(1); load(rA, P, g1, tid); const int g2 = SCAN_CHUNK(2); load(rB, P, g2, tid); }
        __syncthreads();
        for (int n = 0; n < 132; n += 2) {
            store(rA, P, sm + ST_SIZE, tid);
            { const int g = SCAN_CHUNK(n); const int nn = min(n + 3, 131); const int gn = SCAN_CHUNK(nn); step(sm, sm, accS, P, g, h, sl, d, wv, fr, fq, rA, gn); }
            __syncthreads();
            store(rB, P, sm, tid);
            { const int g = SCAN_CHUNK(n + 1); const int nn = min(n + 4, 131); const int gn = SCAN_CHUNK(nn); step(sm, sm + ST_SIZE, accS, P, g, h, sl, d, wv, fr, fq, rB, gn); }
            __syncthreads();
        }
#undef SCAN_CHUNK
    }
}

__device__ void ofinal_phase(const Params& p, unsigned char* ws_, int l, int nrows, int wvs_) {
    const int tid = opaque_tid(wvs_);
    const bf16_t* o0 = (const bf16_t*)(ws_ + WS_PQ); const bf16_t* o1 = (const bf16_t*)(ws_ + WS_PQ + SZ512); bf16_t* bout = (bf16_t*)(ws_ + WS_BOUT);
    const float* g = p.dn_norm_g + l * 128;
    for (int base = bid_() * 8; base < nrows; base += gdim_() * 8) {
        const int tok = base + (tid >> 6), h = (tid >> 4) & 3, part = tid & 15, col = h * 128 + part * 8;
        float a[8], b[8], z[8];
        unpack8(*(const u32x4*)(o0 + (size_t)tok * 512 + col), a); unpack8(*(const u32x4*)(o1 + (size_t)tok * 512 + col), b);
        unpack8(*(const u32x4*)(bout + (size_t)tok * 1024 + col), z);
        float ss = 0.f;
#pragma unroll
        for (int e = 0; e < 8; ++e) { a[e] += b[e]; ss += a[e] * a[e]; }
        { const int ln = tid & 63; ss += lane_get(ss, ln ^ 1); ss += lane_get(ss, ln ^ 2); ss += lane_get(ss, ln ^ 4); ss += lane_get(ss, ln ^ 8); }
        const float rn = rsqrtf(ss * (1.f / 128.f) + EPS);
#pragma unroll
        for (int e = 0; e < 8; ++e) a[e] = a[e] * rn * g[part * 8 + e] * z[e];
        *(u32x4*)(bout + (size_t)tok * 1024 + col) = pack8(a);
    }
}

__device__ void final_phase(const Params& p, const bf16_t* xb, float* out_, int wvs_) {
    const int tid = opaque_tid(wvs_), wave = tid >> 6, lane = tid & 63;
    const int rstride = gdim_() * 8;
    for (int row0 = bid_() * 8 + wave; row0 < ML; row0 += 3 * rstride) {
        f32x4 vv[3][4];
#pragma unroll
        for (int k = 0; k < 3; ++k) { const int row = min(row0 + k * rstride, ML - 1);
#pragma unroll
            for (int j = 0; j < 4; ++j) { const u32x2 w2 = *(const u32x2*)(xb + (size_t)row * 1024 + j * 256 + lane * 4); vv[k][j] = (f32x4){bflo(w2.x), bfhi(w2.x), bflo(w2.y), bfhi(w2.y)}; } }
#pragma unroll
        for (int k = 0; k < 3; ++k) { const int row = row0 + k * rstride; if (row < ML) {
            float* xr = out_ + (size_t)row * 1024; float ss = 0.f;
#pragma unroll
            for (int j = 0; j < 4; ++j) ss += vv[k][j][0] * vv[k][j][0] + vv[k][j][1] * vv[k][j][1] + vv[k][j][2] * vv[k][j][2] + vv[k][j][3] * vv[k][j][3];
#pragma unroll
            for (int o = 32; o >= 1; o >>= 1) ss += lane_get(ss, lane ^ o);
            const float rstd = rsqrtf(ss * (1.f / 1024.f) + EPS);
#pragma unroll
            for (int j = 0; j < 4; ++j) { const int col = j * 256 + lane * 4; const f32x4 gg = *(const f32x4*)(p.final_norm_g + col);
                f32x4 y; y[0] = vv[k][j][0] * rstd * gg[0]; y[1] = vv[k][j][1] * rstd * gg[1]; y[2] = vv[k][j][2] * rstd * gg[2]; y[3] = vv[k][j][3] * rstd * gg[3];
                *(f32x4*)(xr + col) = y; } } }
    }
}

#define XB_TMO      128
#define XB_XCNT(j)  (256  + 64 * (j))
#define XB_XSUB(j)  (1280 + 64 * (j))
#define XB_XGEN(j)  (2304 + 64 * (j))
#define XB_TOP      3328
#define XB_TOPGEN   3392
#define XCD_BAR_WORDS 3456
#define XB_SPIN_CAP (1u << 20)
__device__ __forceinline__ unsigned xb_ld(unsigned* p)              { return __hip_atomic_load(p, __ATOMIC_RELAXED, __HIP_MEMORY_SCOPE_AGENT); }
__device__ __forceinline__ unsigned xb_add(unsigned* p, unsigned v) { return __hip_atomic_fetch_add(p, v, __ATOMIC_RELAXED, __HIP_MEMORY_SCOPE_AGENT); }
__device__ __forceinline__ unsigned xb_xcc_id() { return (unsigned)__builtin_amdgcn_s_getreg((3 << 11) | 20) & 0xFu; }
#define XB_SPIN(cond, bar) do { unsigned _sp = 0; while (cond) { \
    if ((++_sp & 255u) == 0u) { if (xb_ld(&(bar)[XB_TMO])) break; if (_sp > XB_SPIN_CAP) { atomicAdd(&(bar)[XB_TMO], 1u); break; } } } } while (0)
struct XcdBarrier { unsigned* bar; unsigned x; volatile LAS unsigned* st; };
__device__ __forceinline__ XcdBarrier xcd_barrier_post(unsigned* bar, volatile LAS unsigned* st) {
    XcdBarrier b; b.bar = bar; b.x = xb_xcc_id(); b.st = st;
    if (threadIdx.x == 0) (void)xb_add(&bar[XB_XCNT(b.x)], 1u);
    return b;
}
__device__ __forceinline__ void xcd_barrier_complete(unsigned* bar, unsigned x, unsigned& nloc, unsigned& nx) {
    const unsigned G = gridDim.x * gridDim.y * gridDim.z;
    unsigned sum, cnt, mine, sp = 0u;
    for (;;) {
        sum = 0u; cnt = 0u; mine = 0u;
#pragma unroll
        for (unsigned j = 0; j < 16; ++j) { const unsigned c = xb_ld(&bar[XB_XCNT(j)]); sum += c; cnt += (c > 0u) ? 1u : 0u; mine = (j == x) ? c : mine; }
        if (sum == G) break;
        __builtin_amdgcn_s_sleep(1);
        if ((++sp & 255u) == 0u) { if (xb_ld(&bar[XB_TMO])) break; if (sp > XB_SPIN_CAP) { atomicAdd(&bar[XB_TMO], 1u); break; } }
    }
    nloc = mine > 0u ? mine : 1u; nx = cnt > 0u ? cnt : 1u;
}
__device__ __forceinline__ void xcd_barrier(const XcdBarrier& b) {
    asm volatile("s_waitcnt vmcnt(0)" ::: "memory");
    __syncthreads();
    if (threadIdx.x == 0) {
        unsigned* bar = b.bar;
        __builtin_amdgcn_s_waitcnt(0);
        unsigned nloc = b.st[0], nx = b.st[1];
        if (nloc == 0u) { xcd_barrier_complete(bar, b.x, nloc, nx); b.st[0] = nloc; b.st[1] = nx; }
        const unsigned old = xb_add(&bar[XB_XSUB(b.x)], 1u);
        const unsigned gen = old / nloc;
        if (old + 1u == (gen + 1u) * nloc) {
            __builtin_amdgcn_fence(__ATOMIC_RELEASE, "agent");
            asm volatile("s_waitcnt vmcnt(0)" ::: "memory");
            const unsigned og = xb_add(&bar[XB_TOP], 1u);
            const unsigned tg = og / nx;
            if (og + 1u == (tg + 1u) * nx) xb_add(&bar[XB_TOPGEN], 1u);
            else XB_SPIN(xb_ld(&bar[XB_TOPGEN]) == tg, bar);
            __builtin_amdgcn_fence(__ATOMIC_ACQUIRE, "agent");
            xb_add(&bar[XB_XGEN(b.x)], 1u);
            asm volatile("s_waitcnt vmcnt(0)" ::: "memory");
        } else {
            XB_SPIN(xb_ld(&bar[XB_XGEN(b.x)]) == gen, bar);
            __builtin_amdgcn_fence(__ATOMIC_ACQUIRE, "agent");
            asm volatile("s_waitcnt vmcnt(0)" ::: "memory");
        }
    }
    __syncthreads();
}

#ifndef PROBE_MASK
#define PROBE_MASK 0u
#endif
#ifndef PH_MASK
#define PH_MASK 0xFFFF
#endif
constexpr int N_PHASES = 26;
__global__ void __launch_bounds__(512, 2) fwd_megakernel(Params pin) {
    extern __shared__ __attribute__((aligned(16))) unsigned char lds[];
    cg::grid_group grid = cg::this_grid();
    LAS unsigned char* ldsl = (LAS unsigned char*)lds;
    const int G = gridDim.x;
    const int wvs_ = __builtin_amdgcn_readfirstlane(threadIdx.x >> 6);
    const Params& p0 = pin;
    volatile LAS unsigned* bst = (volatile LAS unsigned*)(ldsl + (LDS_BYTES - 64));
    if (threadIdx.x < 2) bst[threadIdx.x] = 0u;
    __syncthreads();
    const XcdBarrier xbar = xcd_barrier_post((unsigned*)(pin.ws + WS_BAR), bst);
    for (int phi = p0.ph_lo; phi < p0.ph_hi; ++phi) {
        int ph = __builtin_amdgcn_readfirstlane(phi); asm volatile("" : "+s"(ph));
        int bx = blockIdx.x; asm volatile("" : "+s"(bx));
        const Params& p = p0;
        size_t zoff_ = 0; asm volatile("" : "+s"(zoff_));
        unsigned char* ws_ = p0.ws + zoff_;
        float* out_ = p0.out + zoff_;
        float* ctxres = (float*)(ws_ + WS_CTX);
        const float* mod = (const float*)(ws_ + WS_MOD);
        bf16_t* hb = (bf16_t*)(ws_ + WS_H);
        bf16_t* side = (bf16_t*)((unsigned char*)out_ + 64 * MiB);
        unsigned long long pt0 = 0; if (PROBE_MASK) pt0 = __builtin_amdgcn_s_memrealtime();
        if (ph == 0) { if (PH_MASK & 0x1000) { mod_phase(p, ws_, lds, wvs_); __syncthreads(); cvt_phase(p, ws_, 0, lds, wvs_); } }
        else if (ph == 25) { if (PH_MASK & 0x2000) final_phase(p, (const bf16_t*)(ws_ + WS_H), out_, wvs_); }
        else {
            const int l = (ph - 1) / 12, sp = (ph - 1) % 12;
            const int Mrows = (l == 0) ? MT : ML;
            const float* xl = (l == 0) ? p.x : out_; const float* xc = (l == 0) ? p.ctx : ctxres;
            switch ((PH_MASK >> sp) & 1 ? sp : 99) {
            case 99: break;
            case 0: if (l == 1) cvt_phase(p, ws_, 1, lds, wvs_); modulate_phase(p, ws_, l, 1, p.x, l == 0 ? nullptr : (const bf16_t*)out_, l == 0 ? (bf16_t*)out_ : nullptr, xc, MT, nullptr, l == 1 ? (const float*)(ws_ + WS_BOUT) : nullptr, 11, mod + (size_t)4 * 6144 + 5120, wvs_); break;
            case 1: { pg8::Gemm g{hb, (const bf16_t*)(ws_ + WS_WIN1), 1024, 1024, 1024, nullptr, nullptr, 0}; pg8::StaticOrder S; S.init(MT, 3328, G, bx);
                pg8::EpiP2 E{(bf16_t*)(ws_ + WS_PQ), side, (float*)(ws_ + WS_AB), (bf16_t*)(ws_ + WS_BOUT)};
                pg8::gemm_phase<pg8::EpiP2, pg8::StaticOrder>(ldsl, g, S, E, wvs_); break; }
            case 2: break;
            case 3: prep_phase(p, ws_, l, lds, wvs_); __syncthreads(); branch_phase(p, ws_, side, l, Mrows, lds, wvs_); break;
            case 4: scan_phase(p, ws_, lds, wvs_); break;
            case 5: ofinal_phase(p, ws_, l, Mrows, wvs_); break;
            case 6: break;
            case 7: { { pg8::Gemm g{(const bf16_t*)(ws_ + WS_BOUT), (const bf16_t*)(ws_ + WS_WBR), 1024, 1024, 512, hb, (const bf16_t*)(ws_ + WS_WG), 1024};
                  pg8::StaticOrder S; S.init(ML, 1024, G, bx); S.fused = 1;
                  pg8::EpiYG E{(bf16_t*)(ws_ + WS_R) + (size_t)bx * 65536, (bf16_t*)(ws_ + WS_PQ)};
                  pg8::gemm_phase<pg8::EpiYG, pg8::StaticOrder, true>(ldsl, g, S, E, wvs_); }
                if (l == 0) {
                  pg8::Gemm g{(const bf16_t*)(ws_ + WS_BOUT), (const bf16_t*)(ws_ + WS_WBR), 1024, 1024, 512, hb, (const bf16_t*)(ws_ + WS_WG), 1024}; pg8::CtxPairOrder S{G, (bx + 64) % G};
                  pg8::EpiYZ E{(bf16_t*)(ws_ + WS_R)};
                  pg8::gemm_phase<pg8::EpiYZ, pg8::CtxPairOrder, true>(ldsl, g, S, E, wvs_); }
                break; }
            case 8: { { pg8::Gemm g{(const bf16_t*)(ws_ + WS_PQ), (const bf16_t*)(ws_ + WS_WO3), 1024, 1024, 1024, nullptr, nullptr, 0}; pg8::StaticOrder S; S.init(ML, 1024, G, bx);
                  pg8::EpiRes E{(const bf16_t*)out_, (bf16_t*)out_, mod + (size_t)l * 5 * 6144 + 2048};
                  pg8::gemm_phase<pg8::EpiRes, pg8::StaticOrder>(ldsl, g, S, E, wvs_); }
                if (l == 0) {
                  pg8::Gemm g{(const bf16_t*)(ws_ + WS_R), (const bf16_t*)(ws_ + WS_WO3), 3072, 1024, 256, nullptr, nullptr, 0}; pg8::CtxOrder<4, 12, 4> S{G, (bx + 32) % G, 512, 512, 1 << 30, 0, 0, 0};
                  pg8::EpiPart E{(float*)(ws_ + WS_BOUT), 12};
                  pg8::gemm_phase<pg8::EpiPart, pg8::CtxOrder<4, 12, 4>>(ldsl, g, S, E, wvs_); }
                break; }
            case 9: modulate_phase(p, ws_, l, 2, p.x, (const bf16_t*)out_, nullptr, l == 0 ? p.ctx : ctxres, Mrows, l == 0 ? ctxres : nullptr, l == 0 ? (const float*)(ws_ + WS_BOUT) : nullptr, 12, mod + (size_t)4 * 6144 + 2048, wvs_); break;
            case 10: { pg8::Gemm g{hb, (const bf16_t*)(ws_ + WS_WGU), 1024, 1024, 1024, nullptr, nullptr, 0}; pg8::StaticOrder S; S.init(Mrows, 2 * DFF, G, bx);
                pg8::EpiSwi E{(bf16_t*)(ws_ + WS_R)};
                pg8::gemm_phase<pg8::EpiSwi, pg8::StaticOrder>(ldsl, g, S, E, wvs_); break; }
            case 11: { { pg8::Gemm g{(const bf16_t*)(ws_ + WS_R), (const bf16_t*)(ws_ + WS_WDN), DFF, DFF, DFF, nullptr, nullptr, 0}; pg8::StaticOrder S; S.init(ML, 1024, G, bx);
                  pg8::EpiRes E{(const bf16_t*)out_, l == 0 ? (bf16_t*)out_ : hb, mod + (size_t)l * 5 * 6144 + 5120};
                  pg8::gemm_phase<pg8::EpiRes, pg8::StaticOrder>(ldsl, g, S, E, wvs_); }
                if (l == 0) {
                  pg8::Gemm g{(const bf16_t*)(ws_ + WS_R), (const bf16_t*)(ws_ + WS_WDN), DFF, DFF, 256, nullptr, nullptr, 0}; pg8::CtxOrder<4, 11, 0> S{G, (bx + 48) % G, 512, 512, 1 << 30, 0, 0, 0};
                  pg8::EpiPart E{(float*)(ws_ + WS_BOUT), 11};
                  pg8::gemm_phase<pg8::EpiPart, pg8::CtxOrder<4, 11, 0>>(ldsl, g, S, E, wvs_); }
                break; }
            }
        }
        if (PROBE_MASK) { if ((PROBE_MASK >> ph) & 1u) { __syncthreads(); const unsigned long long pt1 = __builtin_amdgcn_s_memrealtime(); const unsigned long long tend = pt1 + (pt1 - pt0);
            while (__builtin_amdgcn_s_memrealtime() < tend) __builtin_amdgcn_s_sleep(4); } }
        if (phi + 1 < p0.ph_hi && ph != 19 && ph != 7 && ph != 3 && ph != 15) { if (phi == p0.ph_lo) grid.sync(); else { XcdBarrier xb2 = xbar; xb2.bar = (unsigned*)(ws_ + WS_BAR); xcd_barrier(xb2); } }
    }
}

extern "C" void kernel_launch(void* const* d_in, const int* in_sizes, int n_in, void* d_out, int out_size, void* d_ws, size_t ws_size, hipStream_t stream) {
    static int grid_blocks = 0;
    if (grid_blocks == 0) {
        if (n_in != 23 || out_size != ML * DM || ws_size < WS_END) { fprintf(stderr, "kernel_launch: unexpected shapes (n_in %d out %d ws %zu)\n", n_in, out_size, ws_size); grid_blocks = -1; return; }
        int dev = 0, cus = 0, per_cu = 0;
        hipGetDevice(&dev);
        hipDeviceGetAttribute(&cus, hipDeviceAttributeMultiprocessorCount, dev);
        if (hipFuncSetAttribute((const void*)fwd_megakernel, hipFuncAttributeMaxDynamicSharedMemorySize, LDS_BYTES) != hipSuccess) { fprintf(stderr, "kernel_launch: hipFuncSetAttribute failed\n"); grid_blocks = -1; return; }
        hipOccupancyMaxActiveBlocksPerMultiprocessor(&per_cu, (const void*)fwd_megakernel, 512, LDS_BYTES);
        if (per_cu < 1) { fprintf(stderr, "kernel_launch: occupancy query says %d blocks/CU\n", per_cu); grid_blocks = -1; return; }
        grid_blocks = cus * (per_cu > 1 ? 1 : per_cu);
    }
    if (grid_blocks < 0) return;
    Params p{};
    const float** pp = (const float**)&p;
    for (int i = 0; i < 23; ++i) pp[i] = (const float*)d_in[i];
    p.out = (float*)d_out; p.ws = (unsigned char*)d_ws; p.ph_lo = 0; p.ph_hi = N_PHASES;
    if (hipMemsetAsync((char*)d_ws + WS_BAR, 0, XCD_BAR_WORDS * 4, stream) != hipSuccess) { fprintf(stderr, "memset failed\n"); return; }
    void* args[] = {&p};
    hipError_t e = hipLaunchCooperativeKernel((const void*)fwd_megakernel, dim3(grid_blocks), dim3(512), args, LDS_BYTES, stream);
    if (e != hipSuccess) fprintf(stderr, "cooperative launch failed: %s (grid %d)\n", hipGetErrorString(e), grid_blocks);
}
```

```cpp
#include <hip/hip_runtime.h>
#include <hip/hip_cooperative_groups.h>
#include <cstdio>
#include <cstdint>
namespace cg = cooperative_groups;

#define LAS __attribute__((address_space(3)))
typedef unsigned short bf16_t;
typedef short bf16x8 __attribute__((ext_vector_type(8)));
typedef float f32x4 __attribute__((ext_vector_type(4)));
typedef unsigned u32x4 __attribute__((ext_vector_type(4)));
typedef unsigned u32x2 __attribute__((ext_vector_type(2)));

constexpr int DM = 1024, NB = 4, SEQ = 8192, CTXL = 256;
constexpr int ML = NB * SEQ;
constexpr int MC = NB * CTXL;
constexpr int MT = ML + MC;
constexpr int NIN = 6160, DFF = 2816;
constexpr int NCHUNK = MT / 64;
constexpr float EPS = 1e-6f;
constexpr int LDS_BYTES = 147456;

constexpr size_t MiB = 1u << 20;
constexpr size_t WS_MOD = 0;
constexpr size_t WS_BAR = 512 * 1024;
constexpr size_t WS_AB = 1 * MiB;
constexpr size_t WS_GC = 3 * MiB + 512 * 1024;
constexpr size_t WS_CTX = 5 * MiB;
constexpr size_t WS_WIN1 = 10 * MiB;
constexpr size_t WS_WG = WS_WIN1 + 3328 * 1024 * 2;
constexpr size_t WS_WBR = WS_WG + 3072 * 1024 * 2;
constexpr size_t WS_WO3 = WS_WBR + 3072 * 1024 * 2;
constexpr size_t WS_WGU = WS_WO3 + 1024 * 1024 * 2;
constexpr size_t WS_WDN = WS_WGU + 5632 * 1024 * 2;
constexpr size_t WS_H = 48 * MiB;
constexpr size_t WS_BOUT = 114 * MiB;
constexpr size_t WS_PQ = 180 * MiB;
constexpr size_t WS_R = 279 * MiB;
constexpr size_t SZ512 = (size_t)MT * 512 * 2;
constexpr size_t WS_QN = WS_R, WS_KT = WS_R + SZ512, WS_WB = WS_R + 2 * SZ512, WS_UB = WS_R + 4 * SZ512, WS_AQK = WS_R + 6 * SZ512;
constexpr size_t SZAQK = (size_t)NCHUNK * 4 * 64 * 64 * 2;
constexpr size_t WS_END = WS_AQK + 2 * SZAQK;
static_assert(WS_WDN + 1024 * 2816 * 2 <= WS_H, "weights");
static_assert(WS_END <= 512 * MiB, "ws");

struct Params {
    const float *x, *c, *ctx, *c_ctx, *w_ada, *b_ada, *norm1_g, *norm2_g, *w_in, *dn_conv_w, *dn_a_log, *dn_dt_bias, *dn_norm_g,
        *pool_w, *pool_scale, *sc_conv_w, *w_br_a, *w_br_b, *w_br_c, *w_o, *w_gu, *w_down, *final_norm_g;
    float* out; unsigned char* ws;
    int ph_lo, ph_hi;
};

typedef float f32x2_t __attribute__((ext_vector_type(2)));
typedef __bf16 bf16x2_t __attribute__((ext_vector_type(2)));
__device__ __forceinline__ unsigned pk2(float lo, float hi) { const f32x2_t v = {lo, hi}; const bf16x2_t b = __builtin_convertvector(v, bf16x2_t); return __builtin_bit_cast(unsigned, b); }
__device__ __forceinline__ unsigned f2bf(float f) { return pk2(f, 0.f) & 0xffffu; }
__device__ __forceinline__ float bflo(unsigned w) { return __uint_as_float(w << 16); }
__device__ __forceinline__ float bfhi(unsigned w) { return __uint_as_float(w & 0xffff0000u); }
__device__ __forceinline__ float bf2f(bf16_t h) { return __uint_as_float(((unsigned)h) << 16); }
__device__ __forceinline__ float siluf(float x) { return x * __builtin_amdgcn_rcpf(1.f + __expf(-x)); }
__device__ __forceinline__ float sigmf(float x) { return __builtin_amdgcn_rcpf(1.f + __expf(-x)); }
__device__ __forceinline__ void unpack8(const u32x4 v, float* f) {
    f[0] = bflo(v.x); f[1] = bfhi(v.x); f[2] = bflo(v.y); f[3] = bfhi(v.y); f[4] = bflo(v.z); f[5] = bfhi(v.z); f[6] = bflo(v.w); f[7] = bfhi(v.w);
}
__device__ __forceinline__ u32x4 pack8(const float* f) { u32x4 w; w.x = pk2(f[0], f[1]); w.y = pk2(f[2], f[3]); w.z = pk2(f[4], f[5]); w.w = pk2(f[6], f[7]); return w; }
__device__ __forceinline__ int opaque_tid(int wvs) { int t; asm volatile("v_mbcnt_lo_u32_b32 %0, -1, 0\n\tv_mbcnt_hi_u32_b32 %0, -1, %0" : "=v"(t)); return (wvs << 6) | t; }
__device__ __forceinline__ int bid_() { int b = blockIdx.x; asm volatile("" : "+s"(b)); return b; }
__device__ __forceinline__ int gdim_() { int g = gridDim.x; asm volatile("" : "+s"(g)); return g; }
__device__ __forceinline__ float lane_get(float v, int src_lane) { return __int_as_float(__builtin_amdgcn_ds_bpermute(src_lane << 2, __float_as_int(v))); }
__device__ __forceinline__ bool seq_first(int t) { return t < ML ? ((t & (SEQ - 1)) == 0) : (((t - ML) & (CTXL - 1)) == 0); }
__device__ __forceinline__ bool seq_last(int t) { return t < ML ? ((t & (SEQ - 1)) == SEQ - 1) : (((t - ML) & (CTXL - 1)) == CTXL - 1); }

namespace pg8 {
constexpr int BM = 256, BK = 64, HALF = 128, HTB = HALF * BK * 2, NXCD = 8, WGM = 8;
__device__ __forceinline__ int lds_byte(int r, int c) { const int st = (r >> 4) * 2 + (c >> 5), rr = r & 15, cc = c & 31, ob = rr * 64 + cc * 2; return st * 1024 + (ob ^ (((ob >> 9) & 1) << 5)); }
__device__ __forceinline__ void stage_rc(int b, int& R, int& C) { const int st = b / 1024, sb = b % 1024, swz = sb ^ (((sb >> 9) & 1) << 5); R = (st >> 1) * 16 + swz / 64; C = (st & 1) * 32 + (swz % 64) / 2; }
__device__ __forceinline__ int perm32(int rho) { const int n = rho >> 4, i = rho & 15; return 8 * (i >> 2) + 4 * n + (i & 3); }

struct Unit { int pm, pn, aoff, boff, ks, kind, nt; };
struct Gemm { const bf16_t* A; const bf16_t* Bt; int lda, ldb, K; const bf16_t* A2; const bf16_t* Bt2; int K2; };

struct StaticOrder {
    int nM, nN, nwg, G, c, a_thresh, a_bytes, triple, fused;
    __device__ void init(int M, int N, int G_, int c_) { nM = M / BM; nN = N / BM; nwg = nM * nN; G = G_; c = c_; a_thresh = 1 << 30; a_bytes = 0; triple = 0; fused = 0; }
    __device__ bool next(int i, Unit& u) const {
        const int sub = fused ? i % 6 : (triple ? i % 3 : 0), br = fused ? (sub >> 1) : sub; const long L = (long)(fused ? i / 6 : (triple ? i / 3 : i)) * G + c; if (L >= nwg) return false;
        int wgid = (int)L; { const int q = nwg / NXCD, r = nwg % NXCD, xcd = wgid % NXCD, off = wgid / NXCD; wgid = (xcd < r ? xcd * (q + 1) : r * (q + 1) + (xcd - r) * q) + off; }
        const int nig = WGM * nN, gid = wgid / nig, fm = gid * WGM, gsz = (nM - fm) < WGM ? (nM - fm) : WGM;
        u.pm = fm + ((wgid % nig) % gsz); u.pn = (wgid % nig) / gsz + 4 * br; u.aoff = (u.pn >= a_thresh) ? a_bytes : 0; u.boff = 0; u.ks = 0; u.kind = 0; u.nt = 0;
        if (fused) { u.kind = sub & 1; u.aoff = u.kind ? 0 : (br == 0 ? 0 : (br == 1 ? 1024 : 1536)); u.nt = u.kind ? 16 : (br == 0 ? 8 : 4); }
        return true;
    }
};

template <class Epi, class Sched, bool FUSED = false>
__device__ __forceinline__ void gemm_phase(LAS unsigned char* lds, const Gemm g, const Sched& S, const Epi& E, int wvs_) {
    const int tid = opaque_tid(wvs_), wid = __builtin_amdgcn_readfirstlane(tid >> 6), lane = tid & 63, wr = wid >> 2, wc = wid & 3, fr = lane & 15, fq = lane >> 4;
    const int K = g.K, nt_c = K / BK, lda = g.lda, ldb = g.ldb;
    unsigned voffA[2], voffB[2];
#pragma unroll
    for (int i = 0; i < 2; ++i) { int R, C; stage_rc(tid * 16 + i * 8192, R, C); const int Rb = (R & ~31) + perm32(R & 31);
        voffA[i] = (unsigned)(R * lda + C) * 2u; voffB[i] = (unsigned)(Rb * ldb + C) * 2u; }
    const size_t kstep = (size_t)(BK * 2);
    const size_t hstepA = (size_t)HALF * lda * 2, hstepB = (size_t)HALF * ldb * 2;
    const size_t tstepA = 2 * hstepA, tstepB = 2 * hstepB;
    const unsigned ldsw = (unsigned)wid * 1024u;
    const int aoff = lds_byte(wr * 64 + fr, fq * 8), boff = lds_byte(wc * 32 + fr, fq * 8);
#define PG8_SA(b, h) (((b) * 2 + (h)) * HTB)
#define PG8_SB(b, h) ((4 + (b) * 2 + (h)) * HTB)
#define PG8_STAGE(bufoff, gbase, voff) do { _Pragma("unroll") for (int _i = 0; _i < 2; ++_i) \
        __builtin_amdgcn_global_load_lds((const unsigned*)((const char*)(gbase) + (voff)[_i]), (LAS unsigned*)(lds + (bufoff) + ldsw + _i * 8192), 16, 0, 0); } while (0)
#define PG8_LDA(dst, b, h) do { _Pragma("unroll") for (int m = 0; m < 4; ++m) _Pragma("unroll") for (int k = 0; k < 2; ++k) dst[m][k] = *(const LAS bf16x8*)(lds + PG8_SA(b, h) + aoff + m * 2048 + k * 1024); } while (0)
#define PG8_LDB(dst, b, h) do { _Pragma("unroll") for (int n = 0; n < 2; ++n) _Pragma("unroll") for (int k = 0; k < 2; ++k) dst[n][k] = *(const LAS bf16x8*)(lds + PG8_SB(b, h) + boff + n * 2048 + k * 1024); } while (0)
#define PG8_MMA(ai, bj, At, Bt) do { __builtin_amdgcn_s_setprio(1); _Pragma("unroll") for (int m = 0; m < 4; ++m) _Pragma("unroll") for (int n = 0; n < 2; ++n) _Pragma("unroll") for (int k = 0; k < 2; ++k) \
        acc[ai][bj][m][n] = __builtin_amdgcn_mfma_f32_16x16x32_bf16(Bt[n][k], At[m][k], acc[ai][bj][m][n], 0, 0, 0); __builtin_amdgcn_s_setprio(0); } while (0)
#define PG8_WAIT_V(n) asm volatile("s_waitcnt vmcnt(" #n ")" ::: "memory")
#define PG8_WAIT_L(n) asm volatile("s_waitcnt lgkmcnt(" #n ")" ::: "memory")
#define PG8_BAR __builtin_amdgcn_s_barrier()
#define PG8_SCHED __builtin_amdgcn_sched_barrier(0)
    Unit cur, nxt; int ui = 0;
    if (!S.next(0, cur)) return;
    f32x4 acc[2][2][4][2];
#pragma unroll
    for (int a = 0; a < 2; ++a)
#pragma unroll
        for (int b = 0; b < 2; ++b)
#pragma unroll
            for (int m = 0; m < 4; ++m)
#pragma unroll
                for (int n = 0; n < 2; ++n) acc[a][b][m][n] = (f32x4){0.f, 0.f, 0.f, 0.f};
    bf16x8 At[4][2], B0[2][2], B1[2][2];
    const char* cA = (const char*)((FUSED && cur.kind) ? g.A2 : g.A) + (size_t)cur.pm * tstepA + cur.aoff; const char* cB = (const char*)((FUSED && cur.kind) ? g.Bt2 : g.Bt) + (size_t)cur.pn * tstepB + cur.boff;
    PG8_STAGE(PG8_SB(0, 0), cB, voffB); PG8_STAGE(PG8_SB(0, 1), cB + hstepB, voffB); PG8_STAGE(PG8_SA(0, 0), cA, voffA); PG8_STAGE(PG8_SA(0, 1), cA + hstepA, voffA);
    if (wr == 1) PG8_BAR;
    PG8_WAIT_V(2); PG8_BAR;
    PG8_STAGE(PG8_SB(1, 0), cB + kstep, voffB); PG8_STAGE(PG8_SA(1, 0), cA + kstep, voffA); PG8_STAGE(PG8_SB(1, 1), cB + hstepB + kstep, voffB);
    PG8_WAIT_V(6); PG8_BAR;
    for (;;) {
        const bool has_next = S.next(ui + 1, nxt);
        const char* nA = has_next ? (const char*)((FUSED && nxt.kind) ? g.A2 : g.A) + (size_t)nxt.pm * tstepA + nxt.aoff : cA; const char* nB = has_next ? (const char*)((FUSED && nxt.kind) ? g.Bt2 : g.Bt) + (size_t)nxt.pn * tstepB + nxt.boff : cB;
        const int nt = FUSED ? cur.nt : nt_c;
        for (int t = 0; t < nt; t += 2) {
            const bool last = (t == nt - 2);
            const char* a1 = cA + (size_t)(t + 1) * kstep;
            const char* a2 = last ? nA : cA + (size_t)(t + 2) * kstep; const char* b2 = last ? nB : cB + (size_t)(t + 2) * kstep;
            const char* a3 = a2 + kstep; const char* b3 = b2 + kstep;
            PG8_LDB(B0, 0, 0); PG8_LDB(B1, 0, 1); PG8_SCHED; PG8_LDA(At, 0, 0); PG8_STAGE(PG8_SA(1, 1), a1 + hstepA, voffA);
            PG8_WAIT_V(8); PG8_WAIT_L(0); PG8_BAR; PG8_MMA(0, 0, At, B0); PG8_MMA(0, 1, At, B1); PG8_BAR; PG8_SCHED;
            PG8_LDA(At, 0, 1); PG8_STAGE(PG8_SB(0, 0), b2, voffB); PG8_STAGE(PG8_SB(0, 1), b2 + hstepB, voffB); PG8_STAGE(PG8_SA(0, 0), a2, voffA);
            PG8_WAIT_V(8); PG8_WAIT_L(0); PG8_BAR; PG8_MMA(1, 0, At, B0); PG8_MMA(1, 1, At, B1); PG8_BAR; PG8_SCHED;
            PG8_LDB(B0, 1, 0); PG8_LDB(B1, 1, 1); PG8_SCHED; PG8_LDA(At, 1, 0); PG8_STAGE(PG8_SA(0, 1), a2 + hstepA, voffA);
            PG8_WAIT_V(8); PG8_WAIT_L(0); PG8_BAR; PG8_MMA(0, 0, At, B0); PG8_MMA(0, 1, At, B1); PG8_BAR; PG8_SCHED;
            PG8_LDA(At, 1, 1); PG8_STAGE(PG8_SB(1, 0), b3, voffB); PG8_STAGE(PG8_SB(1, 1), b3 + hstepB, voffB); PG8_STAGE(PG8_SA(1, 0), a3, voffA);
            PG8_WAIT_V(8); PG8_WAIT_L(0); PG8_BAR; PG8_MMA(1, 0, At, B0); PG8_MMA(1, 1, At, B1); PG8_BAR; PG8_SCHED;
        }
        if (wr == 0) PG8_BAR;
        { const int ln2 = opaque_tid(wvs_) & 63; const int fr2 = ln2 & 15, fq2 = ln2 >> 4;
          E(acc, cur, wr, wc, fr2, fq2); }
        if (!has_next) break;
#pragma unroll
        for (int a = 0; a < 2; ++a)
#pragma unroll
            for (int b = 0; b < 2; ++b)
#pragma unroll
                for (int m = 0; m < 4; ++m)
#pragma unroll
                    for (int n = 0; n < 2; ++n) acc[a][b][m][n] = (f32x4){0.f, 0.f, 0.f, 0.f};
        cur = nxt; cA = nA; cB = nB; ++ui;
        if (wr == 1) PG8_BAR;
    }
    PG8_WAIT_V(0);
    PG8_BAR;
#undef PG8_SA
#undef PG8_SB
#undef PG8_STAGE
#undef PG8_LDA
#undef PG8_LDB
#undef PG8_MMA
#undef PG8_WAIT_V
#undef PG8_WAIT_L
#undef PG8_BAR
#undef PG8_SCHED
}

typedef f32x4 Acc[2][2][4][2];

struct EpiP2 {
    bf16_t* pq; bf16_t* prest; float* ab; bf16_t* bout;
    __device__ __forceinline__ void operator()(const Acc& acc, const Unit& u, int wr, int wc, int fr, int fq) const {
        const int row0 = u.pm * BM + wr * 64 + fr, colb = u.pn * BM + wc * 32 + 8 * fq;
        if (u.pn == 9 || u.pn == 10) {
            const int cx = 256 + (u.pn - 9) * 128 + wc * 32 + 8 * fq;
#pragma unroll
            for (int ai = 0; ai < 2; ++ai)
#pragma unroll
                for (int m = 0; m < 4; ++m) { const f32x4 p0 = acc[ai][0][m][0] * acc[ai][1][m][0], p1 = acc[ai][0][m][1] * acc[ai][1][m][1];
                    u32x4 w; w.x = pk2(p0[0], p0[1]); w.y = pk2(p0[2], p0[3]); w.z = pk2(p1[0], p1[1]); w.w = pk2(p1[2], p1[3]);
                    *(u32x4*)(prest + (size_t)(row0 + ai * HALF + m * 16) * 768 + cx) = w; }
            return; }
#pragma unroll
        for (int ai = 0; ai < 2; ++ai)
#pragma unroll
            for (int m = 0; m < 4; ++m) { const size_t row = (size_t)(row0 + ai * HALF + m * 16);
#pragma unroll
                for (int bj = 0; bj < 2; ++bj) { const int col = colb + bj * HALF; const f32x4 v0 = acc[ai][bj][m][0], v1 = acc[ai][bj][m][1];
                    if (col >= 1536 && col < 2048) { u32x4 w; w.x = pk2(siluf(v0[0]), siluf(v0[1])); w.y = pk2(siluf(v0[2]), siluf(v0[3])); w.z = pk2(siluf(v1[0]), siluf(v1[1])); w.w = pk2(siluf(v1[2]), siluf(v1[3]));
                        *(u32x4*)(bout + row * 1024 + (col - 1536)) = w; }
                    else if (col < 3072) { u32x4 w; w.x = pk2(v0[0], v0[1]); w.y = pk2(v0[2], v0[3]); w.z = pk2(v1[0], v1[1]); w.w = pk2(v1[2], v1[3]);
                        if (col < 1536) *(u32x4*)(pq + row * 1536 + col) = w; else *(u32x4*)(prest + row * 768 + (col < 2304 ? col - 2048 : col - 2304)) = w; }
                    else if (col < 3088) { float* p = ab + row * 16 + (col - 3072); *(f32x4*)p = v0; *(f32x4*)(p + 4) = v1; } } }
    }
};
struct EpiY {
    bf16_t* O; int ldc;
    __device__ __forceinline__ void operator()(const Acc& acc, const Unit& u, int wr, int wc, int fr, int fq) const {
        const int row0 = u.pm * BM + wr * 64 + fr, colb = u.pn * BM + wc * 32 + 8 * fq;
#pragma unroll
        for (int ai = 0; ai < 2; ++ai)
#pragma unroll
            for (int m = 0; m < 4; ++m) { bf16_t* rowp = O + (size_t)(row0 + ai * HALF + m * 16) * ldc + colb;
#pragma unroll
                for (int bj = 0; bj < 2; ++bj) { const f32x4 v0 = acc[ai][bj][m][0], v1 = acc[ai][bj][m][1];
                    u32x4 w; w.x = pk2(v0[0], v0[1]); w.y = pk2(v0[2], v0[3]); w.z = pk2(v1[0], v1[1]); w.w = pk2(v1[2], v1[3]);
                    *(u32x4*)(rowp + bj * HALF) = w; } }
    }
};
struct EpiG {
    const bf16_t* Y; bf16_t* O;
    __device__ __forceinline__ void operator()(const Acc& acc, const Unit& u, int wr, int wc, int fr, int fq) const {
        const int row0 = u.pm * BM + wr * 64 + fr, colb = u.pn * BM + wc * 32 + 8 * fq, br = u.pn >> 2, colo = colb - br * 1024;
#pragma unroll
        for (int ai = 0; ai < 2; ++ai)
#pragma unroll
            for (int m = 0; m < 4; ++m) { const size_t row = (size_t)(row0 + ai * HALF + m * 16);
#pragma unroll
                for (int bj = 0; bj < 2; ++bj) { const f32x4 v0 = acc[ai][bj][m][0], v1 = acc[ai][bj][m][1];
                    const u32x4 y = *(const u32x4*)(Y + row * 3072 + colb + bj * HALF);
                    float f[8];
                    f[0] = sigmf(v0[0]) * bflo(y.x); f[1] = sigmf(v0[1]) * bfhi(y.x); f[2] = sigmf(v0[2]) * bflo(y.y); f[3] = sigmf(v0[3]) * bfhi(y.y);
                    f[4] = sigmf(v1[0]) * bflo(y.z); f[5] = sigmf(v1[1]) * bfhi(y.z); f[6] = sigmf(v1[2]) * bflo(y.w); f[7] = sigmf(v1[3]) * bfhi(y.w);
                    bf16_t* op = O + row * 1024 + colo + bj * HALF;
                    if (br > 0) { float o[8]; unpack8(*(const u32x4*)op, o);
#pragma unroll
                        for (int e = 0; e < 8; ++e) f[e] += o[e]; }
                    *(u32x4*)op = pack8(f); } }
    }
};
struct EpiYG {
    bf16_t* ring; bf16_t* O;
    __device__ __forceinline__ void operator()(const Acc& acc, const Unit& u, int wr, int wc, int fr, int fq) const {
        const int rl = wr * 64 + fr, cl = wc * 32 + 8 * fq;
        if (u.kind == 0) {
#pragma unroll
            for (int ai = 0; ai < 2; ++ai)
#pragma unroll
                for (int m = 0; m < 4; ++m)
#pragma unroll
                    for (int bj = 0; bj < 2; ++bj) { const f32x4 v0 = acc[ai][bj][m][0], v1 = acc[ai][bj][m][1];
                        u32x4 w; w.x = pk2(v0[0], v0[1]); w.y = pk2(v0[2], v0[3]); w.z = pk2(v1[0], v1[1]); w.w = pk2(v1[2], v1[3]);
                        *(u32x4*)(ring + (rl + ai * HALF + m * 16) * 256 + cl + bj * HALF) = w; }
        } else {
            const int row0 = u.pm * BM + rl, br = u.pn >> 2, colo = (u.pn & 3) * BM + cl;
#pragma unroll
            for (int ai = 0; ai < 2; ++ai)
#pragma unroll
                for (int m = 0; m < 4; ++m) { const size_t row = (size_t)(row0 + ai * HALF + m * 16);
#pragma unroll
                    for (int bj = 0; bj < 2; ++bj) { const f32x4 v0 = acc[ai][bj][m][0], v1 = acc[ai][bj][m][1];
                        const u32x4 y = *(const u32x4*)(ring + (rl + ai * HALF + m * 16) * 256 + cl + bj * HALF);
                        float f[8];
                        f[0] = sigmf(v0[0]) * bflo(y.x); f[1] = sigmf(v0[1]) * bfhi(y.x); f[2] = sigmf(v0[2]) * bflo(y.y); f[3] = sigmf(v0[3]) * bfhi(y.y);
                        f[4] = sigmf(v1[0]) * bflo(y.z); f[5] = sigmf(v1[1]) * bfhi(y.z); f[6] = sigmf(v1[2]) * bflo(y.w); f[7] = sigmf(v1[3]) * bfhi(y.w);
                        bf16_t* op = O + row * 1024 + colo + bj * HALF;
                        if (br > 0) { float o[8]; unpack8(*(const u32x4*)op, o);
#pragma unroll
                            for (int e = 0; e < 8; ++e) f[e] += o[e]; }
                        *(u32x4*)op = pack8(f); } }
        }
    }
};
struct EpiRes {
    const bf16_t* res_bf; bf16_t* out_bf; const float* gate;
    __device__ __forceinline__ void operator()(const Acc& acc, const Unit& u, int wr, int wc, int fr, int fq) const {
        const int row0 = u.pm * BM + wr * 64 + fr, colb = u.pn * BM + wc * 32 + 8 * fq;
        const int gr = (u.pm * BM) >> 13;
        f32x4 gv[2][2];
#pragma unroll
        for (int bj = 0; bj < 2; ++bj)
#pragma unroll
            for (int n = 0; n < 2; ++n) gv[bj][n] = *(const f32x4*)(gate + gr * 6144 + colb + bj * HALF + 4 * n);
#pragma unroll
        for (int ai = 0; ai < 2; ++ai)
#pragma unroll
            for (int m = 0; m < 4; ++m) { const size_t ro = (size_t)(row0 + ai * HALF + m * 16) * 1024 + colb;
#pragma unroll
                for (int bj = 0; bj < 2; ++bj) { const u32x4 rv = *(const u32x4*)(res_bf + ro + bj * HALF);
                    const f32x4 a0 = gv[bj][0] * acc[ai][bj][m][0], a1 = gv[bj][1] * acc[ai][bj][m][1];
                    u32x4 w; w.x = pk2(bflo(rv.x) + a0[0], bfhi(rv.x) + a0[1]); w.y = pk2(bflo(rv.y) + a0[2], bfhi(rv.y) + a0[3]);
                    w.z = pk2(bflo(rv.z) + a1[0], bfhi(rv.z) + a1[1]); w.w = pk2(bflo(rv.w) + a1[2], bfhi(rv.w) + a1[3]);
                    *(u32x4*)(out_bf + ro + bj * HALF) = w; } }
    }
};
struct EpiSwi {
    bf16_t* H;
    __device__ __forceinline__ void operator()(const Acc& acc, const Unit& u, int wr, int wc, int fr, int fq) const {
        const int row0 = u.pm * BM + wr * 64 + fr, colb = u.pn * HALF + wc * 32 + 8 * fq;
#pragma unroll
        for (int ai = 0; ai < 2; ++ai)
#pragma unroll
            for (int m = 0; m < 4; ++m) { bf16_t* rowp = H + (size_t)(row0 + ai * HALF + m * 16) * DFF + colb;
                const f32x4 g0 = acc[ai][0][m][0], g1 = acc[ai][0][m][1], u0 = acc[ai][1][m][0], u1 = acc[ai][1][m][1];
                u32x4 w;
                w.x = pk2(siluf(g0[0]) * u0[0], siluf(g0[1]) * u0[1]); w.y = pk2(siluf(g0[2]) * u0[2], siluf(g0[3]) * u0[3]);
                w.z = pk2(siluf(g1[0]) * u1[0], siluf(g1[1]) * u1[1]); w.w = pk2(siluf(g1[2]) * u1[2], siluf(g1[3]) * u1[3]);
                *(u32x4*)rowp = w; }
    }
};

template <int NN, int NSPLIT, int BMOD> struct CtxOrder {
    int G, c, a_step, b_step, a_thresh, a_bytes, pn_off, a_base;
    __device__ bool next(int i, Unit& u) const {
        const int L = i * G + c; if (L >= 4 * NN * NSPLIT) return false;
        const int ks = L % NSPLIT, t = L / NSPLIT; u.pn = t % NN + pn_off; u.pm = 128 + t / NN; u.ks = ks; u.kind = 0; u.nt = 0; u.aoff = a_base + ks * a_step + (u.pn >= a_thresh ? a_bytes : 0); u.boff = (BMOD ? (ks % BMOD) : ks) * b_step; return true;
    }
};
struct EpiZ {
    bf16_t* Z;
    __device__ __forceinline__ void operator()(const Acc& acc, const Unit& u, int wr, int wc, int fr, int fq) const {
        const int row0 = u.pm * BM + wr * 64 + fr, colb = u.pn * BM + wc * 32 + 8 * fq;
#pragma unroll
        for (int ai = 0; ai < 2; ++ai)
#pragma unroll
            for (int m = 0; m < 4; ++m) { bf16_t* rowp = Z + (size_t)(row0 + ai * HALF + m * 16) * 3072 + colb;
#pragma unroll
                for (int bj = 0; bj < 2; ++bj) { const f32x4 v0 = acc[ai][bj][m][0], v1 = acc[ai][bj][m][1];
                    const u32x4 y = *(const u32x4*)(rowp + bj * HALF);
                    u32x4 w;
                    w.x = pk2(sigmf(v0[0]) * bflo(y.x), sigmf(v0[1]) * bfhi(y.x)); w.y = pk2(sigmf(v0[2]) * bflo(y.y), sigmf(v0[3]) * bfhi(y.y));
                    w.z = pk2(sigmf(v1[0]) * bflo(y.z), sigmf(v1[1]) * bfhi(y.z)); w.w = pk2(sigmf(v1[2]) * bflo(y.w), sigmf(v1[3]) * bfhi(y.w));
                    *(u32x4*)(rowp + bj * HALF) = w; } }
    }
};
struct CtxPairOrder {
    int G, c;
    __device__ bool next(int i, Unit& u) const {
        const int t = (i >> 1) * G + c; if (t >= 48) return false;
        u.kind = i & 1; u.pn = t % 12; u.pm = 128 + t / 12; u.boff = 0; u.ks = 0;
        const int br = u.pn >> 2; u.aoff = u.kind ? 0 : (br == 0 ? 0 : (br == 1 ? 1024 : 1536)); u.nt = u.kind ? 16 : (br == 0 ? 8 : 4); return true;
    }
};
struct EpiYZ {
    bf16_t* Ycat;
    __device__ __forceinline__ void operator()(const Acc& acc, const Unit& u, int wr, int wc, int fr, int fq) const {
        if (u.kind == 0) { EpiY e{Ycat, 3072}; e(acc, u, wr, wc, fr, fq); } else { EpiZ e{Ycat}; e(acc, u, wr, wc, fr, fq); }
    }
};
struct EpiPart {
    float* part; int nsplit_unused;
    __device__ __forceinline__ void operator()(const Acc& acc, const Unit& u, int wr, int wc, int fr, int fq) const {
        const int row0 = (u.pm - 128) * BM + wr * 64 + fr, colb = u.pn * BM + wc * 32 + 8 * fq;
        float* base = part + (size_t)u.ks * (MC * 1024) + (size_t)row0 * 1024 + colb;
#pragma unroll
        for (int ai = 0; ai < 2; ++ai)
#pragma unroll
            for (int m = 0; m < 4; ++m) { float* ro = base + (size_t)(ai * HALF + m * 16) * 1024;
#pragma unroll
                for (int bj = 0; bj < 2; ++bj)
#pragma unroll
                    for (int n = 0; n < 2; ++n) *(f32x4*)(ro + bj * HALF + 4 * n) = acc[ai][bj][m][n]; }
    }
};
}

__device__ __forceinline__ const float* wsrc(const Params& p, int l, int buf, int n, int k) {
    switch (buf) {
    case 0: { int c;
        if (n < 2048) c = n; else if (n < 2304) c = n + 16;
        else if (n < 2816) { const int t = (n - 2304) >> 8, w = (n - 2304) & 255; c = w < 128 ? 2320 + t * 128 + w : 2832 + t * 128 + (w - 128); }
        else if (n < 3072) c = n - 240; else c = n < 3088 ? n - 1024 : -1;
        if (c < 0) return nullptr; return p.w_in + (size_t)l * 1024 * NIN + (size_t)k * NIN + c; }
    case 1: return p.w_in + (size_t)l * 1024 * NIN + (size_t)k * NIN + 3088 + n;
    case 2: { const int br = n >> 10, nn = n & 1023;
        if (br == 0) return p.w_br_a + (size_t)l * 512 * 1024 + (size_t)k * 1024 + nn;
        if (br == 1) return k < 256 ? p.w_br_b + (size_t)l * 256 * 1024 + (size_t)k * 1024 + nn : nullptr;
        return k < 256 ? p.w_br_c + (size_t)l * 256 * 1024 + (size_t)k * 1024 + nn : nullptr; }
    case 3: return p.w_o + (size_t)l * 1024 * 1024 + (size_t)k * 1024 + n;
    case 4: { const int t = n >> 8, w = n & 255; const int c = w < 128 ? t * 128 + w : DFF + t * 128 + (w - 128); return p.w_gu + (size_t)l * 1024 * 2 * DFF + (size_t)k * 2 * DFF + c; }
    default: return p.w_down + (size_t)l * DFF * 1024 + (size_t)k * 1024 + n;
    }
}
struct CvtTile { int buf, K, n0, k0, pitch; size_t off; };
__device__ __forceinline__ CvtTile cvt_decode(int item) {
    const int cumt[7] = {0, 832, 1600, 1984, 2240, 3648, 4352};
    const int Ks[6] = {1024, 1024, 512, 1024, 1024, 2816};
    const size_t offs[6] = {WS_WIN1, WS_WG, WS_WBR, WS_WO3, WS_WGU, WS_WDN};
    CvtTile t; t.buf = 0;
#pragma unroll
    for (int b = 1; b < 6; ++b) if (item >= cumt[b]) t.buf = b;
    t.K = 1024; int base = 0; t.off = WS_WIN1;
#pragma unroll
    for (int b = 0; b < 6; ++b) if (t.buf == b) { t.K = Ks[b]; base = cumt[b]; t.off = offs[b]; }
    const int it = item - base, nkt = t.K / 64; t.k0 = (it % nkt) * 64; t.n0 = (it / nkt) * 64; t.pitch = (t.buf == 2) ? 1024 : t.K; return t;
}
__device__ void cvt_phase(const Params& p, unsigned char* ws_, int l, unsigned char* sm, int wvs_) {
    float* tile = (float*)sm;
    const int tid = opaque_tid(wvs_);
    constexpr int NT_ALL = 4352;
    for (int item = bid_(); item < NT_ALL; item += 2 * gdim_()) {
        CvtTile T[2]; T[0] = cvt_decode(item); const bool has2 = item + gdim_() < NT_ALL; T[1] = cvt_decode(has2 ? item + gdim_() : item);
        f32x4 v[2][2];
#pragma unroll
        for (int q = 0; q < 2; ++q)
#pragma unroll
            for (int r = 0; r < 2; ++r) { const int f4i = tid + 512 * r, kk = f4i >> 4, n4 = (f4i & 15) * 4;
                const float* src = wsrc(p, l, T[q].buf, T[q].n0 + n4, T[q].k0 + kk); v[q][r] = src ? *(const f32x4*)src : (f32x4){0.f, 0.f, 0.f, 0.f}; }
#pragma unroll
        for (int q = 0; q < 2; ++q)
#pragma unroll
            for (int r = 0; r < 2; ++r) { const int f4i = tid + 512 * r, kk = f4i >> 4, n4 = (f4i & 15) * 4;
#pragma unroll
                for (int e = 0; e < 4; ++e) tile[q * 4160 + kk * 65 + n4 + e] = v[q][r][e]; }
        __syncthreads();
#pragma unroll
        for (int q = 0; q < 2; ++q) { if (q == 0 || has2) { const int nn = tid >> 3, kg = tid & 7; float f[8];
#pragma unroll
            for (int i = 0; i < 8; ++i) f[i] = tile[q * 4160 + (kg * 8 + i) * 65 + nn];
            *(u32x4*)((bf16_t*)(ws_ + T[q].off) + (size_t)(T[q].n0 + nn) * T[q].pitch + T[q].k0 + kg * 8) = pack8(f); } }
        __syncthreads();
    }
}

__device__ void mod_phase(const Params& p, unsigned char* ws_, unsigned char* sm, int wvs_) {
    float* scv = (float*)sm; float* red = scv + 5120; float* mod = (float*)(ws_ + WS_MOD);
    const int tid = opaque_tid(wvs_);
    for (int i = tid; i < 5120; i += 512) { const int r = i >> 10, k = i & 1023; const float v = r < 4 ? p.c[r * 1024 + k] : p.c_ctx[k]; scv[i] = siluf(v); }
    __syncthreads();
    for (int item = bid_(); item < 192; item += gdim_()) {
        const int l = item / 96, cb = item % 96, cn = tid & 63, kg = tid >> 6, n = cb * 64 + cn;
        const float* W = p.w_ada + (size_t)l * 1024 * 6144;
        float a0 = 0, a1 = 0, a2 = 0, a3 = 0, a4 = 0;
        for (int kk = 0; kk < 128; ++kk) { const int k = kg * 128 + kk; const float w = W[(size_t)k * 6144 + n];
            a0 += scv[k] * w; a1 += scv[1024 + k] * w; a2 += scv[2048 + k] * w; a3 += scv[3072 + k] * w; a4 += scv[4096 + k] * w; }
        red[(kg * 5 + 0) * 64 + cn] = a0; red[(kg * 5 + 1) * 64 + cn] = a1; red[(kg * 5 + 2) * 64 + cn] = a2; red[(kg * 5 + 3) * 64 + cn] = a3; red[(kg * 5 + 4) * 64 + cn] = a4;
        __syncthreads();
        if (tid < 320) { const int r = tid >> 6, c2 = tid & 63; float s = 0; for (int q = 0; q < 8; ++q) s += red[(q * 5 + r) * 64 + c2];
            mod[(size_t)(l * 5 + r) * 6144 + cb * 64 + c2] = s + p.b_ada[l * 6144 + cb * 64 + c2]; }
        __syncthreads();
    }
}

__device__ __forceinline__ const float* mod_rowptr(const float* src_lat, const float* src_ctx, int row) { return row < ML ? src_lat + (size_t)row * 1024 : src_ctx + (size_t)(row - ML) * 1024; }
__device__ void modulate_phase(const Params& p, unsigned char* ws_, int l, int which, const float* src_lat, const bf16_t* src_lat_bf, bf16_t* copy_lat_bf, const float* src_ctx, int nrows, float* copy_ctx, const float* part, int nsplit, const float* pgate, int wvs_) {
    const int tid = opaque_tid(wvs_), wave = tid >> 6, lane = tid & 63;
    const float* mod = (const float*)(ws_ + WS_MOD); bf16_t* hb = (bf16_t*)(ws_ + WS_H);
    const float* g = (which == 1 ? p.norm1_g : p.norm2_g) + l * 1024;
    const int rstride = gdim_() * 8;
    for (int row0 = bid_() * 8 + wave; row0 < nrows; row0 += 3 * rstride) {
        f32x4 vv[3][4];
#pragma unroll
        for (int k = 0; k < 3; ++k) { const int row = min(row0 + k * rstride, nrows - 1);
            if (src_lat_bf && row < ML) {
#pragma unroll
                for (int j = 0; j < 4; ++j) { const u32x2 w2 = *(const u32x2*)(src_lat_bf + (size_t)row * 1024 + j * 256 + lane * 4); vv[k][j] = (f32x4){bflo(w2.x), bfhi(w2.x), bflo(w2.y), bfhi(w2.y)}; } }
            else { const float* xr = mod_rowptr(src_lat, src_ctx, row);
#pragma unroll
                for (int j = 0; j < 4; ++j) vv[k][j] = __builtin_nontemporal_load((const f32x4*)(xr + j * 256 + lane * 4)); } }
#pragma unroll
        for (int k = 0; k < 3; ++k) { const int row = row0 + k * rstride; if (row < nrows) {
            const int mr = row < ML ? (row >> 13) : 4;
            const float* shift = mod + (size_t)(l * 5 + mr) * 6144 + (which == 1 ? 0 : 3072); const float* scale = shift + 1024;
            f32x4 v[4]; float ss = 0.f;
#pragma unroll
            for (int j = 0; j < 4; ++j) { v[j] = vv[k][j]; ss += v[j][0] * v[j][0] + v[j][1] * v[j][1] + v[j][2] * v[j][2] + v[j][3] * v[j][3]; }
            if (part && row >= ML) {
                ss = 0.f;
#pragma unroll
                for (int j = 0; j < 4; ++j) { const int col = j * 256 + lane * 4; f32x4 a4 = {0.f, 0.f, 0.f, 0.f};
                    for (int ks = 0; ks < nsplit; ++ks) a4 += *(const f32x4*)(part + (size_t)ks * (MC * 1024) + (size_t)(row - ML) * 1024 + col);
                    v[j] += *(const f32x4*)(pgate + col) * a4;
                    ss += v[j][0] * v[j][0] + v[j][1] * v[j][1] + v[j][2] * v[j][2] + v[j][3] * v[j][3]; } }
            if (copy_lat_bf && row < ML) {
#pragma unroll
                for (int j = 0; j < 4; ++j) { u32x2 w2; w2.x = pk2(v[j][0], v[j][1]); w2.y = pk2(v[j][2], v[j][3]); *(u32x2*)(copy_lat_bf + (size_t)row * 1024 + j * 256 + lane * 4) = w2; } }
            if (copy_ctx && row >= ML) {
#pragma unroll
                for (int j = 0; j < 4; ++j) *(f32x4*)(copy_ctx + (size_t)(row - ML) * 1024 + j * 256 + lane * 4) = v[j]; }
#pragma unroll
            for (int o = 32; o >= 1; o >>= 1) ss += lane_get(ss, lane ^ o);
            const float rstd = rsqrtf(ss * (1.f / 1024.f) + EPS);
#pragma unroll
            for (int j = 0; j < 4; ++j) { const int col = j * 256 + lane * 4;
                const f32x4 gg = *(const f32x4*)(g + col), sc = *(const f32x4*)(scale + col), sh = *(const f32x4*)(shift + col);
                float y[4];
#pragma unroll
                for (int e = 0; e < 4; ++e) y[e] = v[j][e] * rstd * gg[e] * (1.f + sc[e]) + sh[e];
                u32x2 w; w.x = pk2(y[0], y[1]); w.y = pk2(y[2], y[3]);
                *(u32x2*)(hb + (size_t)row * 1024 + col) = w; } } }
    }
}

__device__ void branch_phase(const Params& p, unsigned char* ws_, const bf16_t* prest, int l, int nrows, unsigned char* sm, int wvs_) {
    const int tid = opaque_tid(wvs_), wv = __builtin_amdgcn_readfirstlane(tid >> 6), lane = tid & 63, fr = lane & 15, fq = lane >> 4;
    sm += (tid >> 10);
    bf16_t* bout = (bf16_t*)(ws_ + WS_BOUT);
    { const int gd = gdim_(), bd = bid_(), nextra = (NCHUNK * 4) % gd;
      const int n = nrows * 32, stride = (gd - nextra) * 512; const float* cw = p.sc_conv_w + l * 768;
      for (int i0 = (bd >= nextra) ? (bd - nextra) * 512 + tid : n; i0 < n; i0 += stride * 4) {
          u32x4 v0[4], vb[4], vm[4], vp[4];
#pragma unroll
          for (int k = 0; k < 4; ++k) { const int idx = min(i0 + k * stride, n - 1), tok = idx >> 5, c = (idx & 31) * 8;
              const bf16_t* r0 = prest + (size_t)tok * 768; const bf16_t* rm = seq_first(tok) ? r0 : r0 - 768; const bf16_t* rp = seq_last(tok) ? r0 : r0 + 768;
              v0[k] = *(const u32x4*)(r0 + 256 + c); vb[k] = *(const u32x4*)(r0 + 512 + c); vm[k] = *(const u32x4*)(rm + 256 + c); vp[k] = *(const u32x4*)(rp + 256 + c); }
#pragma unroll
          for (int k = 0; k < 4; ++k) { const int idx = i0 + k * stride; if (idx < n) { const int tok = idx >> 5, c = (idx & 31) * 8; const bool fst = seq_first(tok), lst = seq_last(tok);
              float a0[8], b0[8], am[8], ap[8], y[8];
              unpack8(v0[k], a0); unpack8(vb[k], b0); unpack8(vm[k], am); unpack8(vp[k], ap);
#pragma unroll
              for (int e = 0; e < 8; ++e) y[e] = b0[e] * ((fst ? 0.f : am[e]) * cw[c + e] + a0[e] * cw[256 + c + e] + (lst ? 0.f : ap[e]) * cw[512 + c + e]);
              *(u32x4*)(bout + (size_t)tok * 1024 + 768 + c) = pack8(y); } } } }
    float* V = (float*)sm; bf16_t* Dm = (bf16_t*)(sm + 16640); bf16_t* WpT = (bf16_t*)(sm + 16640 + 9216);
    const int nitems = (nrows > ML) ? (512 + 16) * 4 : 512 * 4;
    for (int item = bid_(); item < nitems; item += gdim_()) {
        const int gi = item & 3, rb = item >> 2, w = 2 << gi, lo = w >> 1, hi = w - 1 - lo;
        { const int ch = tid >> 3, dd0 = (tid & 7) * 8; const float* wp = p.pool_w + (size_t)(l * 4 + gi) * 4096 + ch * 64 + dd0;
          const f32x4 w0 = *(const f32x4*)wp, w1 = *(const f32x4*)(wp + 4);
#pragma unroll
          for (int e = 0; e < 4; ++e) { WpT[(dd0 + e) * 72 + ch] = (bf16_t)f2bf(w0[e]); WpT[(dd0 + 4 + e) * 72 + ch] = (bf16_t)f2bf(w1[e]); } }
        const int c = tid >> 3, cg8 = tid & 7, ch0 = cg8 * 8, colb = gi * 64 + ch0;
        float own[8], acc[8], d[8]; int tokbase;
#pragma unroll
        for (int e = 0; e < 8; ++e) acc[e] = 0.f;
        if (rb < 512) {
            const int b = rb >> 7, r = rb & 127, r0 = max(r - lo, 0), r1 = min(r + hi, 127); tokbase = b * SEQ + r * 64;
            u32x4 vv[16];
#pragma unroll
            for (int k = 0; k < 16; ++k) { const int rr = min(r0 + k, r1); vv[k] = *(const u32x4*)(prest + (size_t)(b * SEQ + rr * 64 + c) * 768 + colb); }
            unpack8(*(const u32x4*)(prest + (size_t)(tokbase + c) * 768 + colb), own);
#pragma unroll
            for (int k = 0; k < 16; ++k) { if (r0 + k <= r1) { float f[8]; unpack8(vv[k], f);
#pragma unroll
                for (int e = 0; e < 8; ++e) acc[e] += f[e]; } }
#pragma unroll
            for (int e = 0; e < 8; ++e) V[c * 65 + ch0 + e] = acc[e];
            __syncthreads();
            const int c0 = max(c - lo, 0), c1 = min(c + hi, 63); const float inv = 1.f / (float)((r1 - r0 + 1) * (c1 - c0 + 1));
            float s8[8];
#pragma unroll
            for (int e = 0; e < 8; ++e) s8[e] = 0.f;
            for (int cc = c0; cc <= c1; ++cc) {
#pragma unroll
                for (int e = 0; e < 8; ++e) s8[e] += V[cc * 65 + ch0 + e]; }
#pragma unroll
            for (int e = 0; e < 8; ++e) d[e] = s8[e] * inv - own[e];
        } else {
            const int cb = rb - 512, b = cb >> 2, s0 = (cb & 3) * 64 + c, sa = max(s0 - lo, 0), sb = min(s0 + hi, CTXL - 1); tokbase = ML + cb * 64;
            u32x4 vv[16];
#pragma unroll
            for (int k = 0; k < 16; ++k) { const int s2 = min(sa + k, sb); vv[k] = *(const u32x4*)(prest + (size_t)(ML + b * CTXL + s2) * 768 + colb); }
            unpack8(*(const u32x4*)(prest + (size_t)(tokbase + c) * 768 + colb), own);
#pragma unroll
            for (int k = 0; k < 16; ++k) { if (sa + k <= sb) { float f[8]; unpack8(vv[k], f);
#pragma unroll
                for (int e = 0; e < 8; ++e) acc[e] += f[e]; } }
            const float inv = 1.f / (float)(sb - sa + 1);
#pragma unroll
            for (int e = 0; e < 8; ++e) d[e] = acc[e] * inv - own[e];
            __syncthreads();
        }
        *(u32x4*)(Dm + c * 72 + ch0) = pack8(d);
        __syncthreads();
        { const int mt = wv & 3; const float* ps = p.pool_scale + l * 256 + gi * 64;
          const bf16x8 d0 = *(const bf16x8*)(Dm + (mt * 16 + fr) * 72 + fq * 8), d1 = *(const bf16x8*)(Dm + (mt * 16 + fr) * 72 + 32 + fq * 8);
#pragma unroll
          for (int q = 0; q < 2; ++q) { const int nt = (wv >> 2) * 2 + q; f32x4 o = {0.f, 0.f, 0.f, 0.f};
              o = __builtin_amdgcn_mfma_f32_16x16x32_bf16(*(const bf16x8*)(WpT + (nt * 16 + fr) * 72 + fq * 8), d0, o, 0, 0, 0);
              o = __builtin_amdgcn_mfma_f32_16x16x32_bf16(*(const bf16x8*)(WpT + (nt * 16 + fr) * 72 + 32 + fq * 8), d1, o, 0, 0, 0);
              const f32x4 sc = *(const f32x4*)(ps + nt * 16 + fq * 4);
              u32x2 wo; wo.x = pk2(o[0] * sc[0], o[1] * sc[1]); wo.y = pk2(o[2] * sc[2], o[3] * sc[3]);
              *(u32x2*)(bout + (size_t)(tokbase + mt * 16 + fr) * 1024 + 512 + gi * 64 + nt * 16 + fq * 4) = wo; } }
        __syncthreads();
    }
}

__device__ void prep_phase(const Params& p, unsigned char* ws_, int l, unsigned char* sm, int wvs_) {
    constexpr int OFF_Q = 0, OFF_K = 17408, OFF_VT = 36864, OFF_KT = 55296, OFF_A = 73728, OFF_G = 106496, OFF_TF = 108544;
    const int tid0_ = opaque_tid(wvs_); sm += (tid0_ >> 10);
    bf16_t* qS = (bf16_t*)(sm + OFF_Q); bf16_t* kS = (bf16_t*)(sm + OFF_K); bf16_t* TS = (bf16_t*)sm;
    bf16_t* vT = (bf16_t*)(sm + OFF_VT); bf16_t* kT = (bf16_t*)(sm + OFF_KT);
    float* Lm = (float*)(sm + OFF_A); float* Tm = (float*)(sm + OFF_TF); float* Xs = (float*)sm; float* gS = (float*)(sm + OFF_G); float* betaS = gS + 128; float* gcS = gS + 256;
    const int tid = opaque_tid(wvs_), wv = __builtin_amdgcn_readfirstlane(tid >> 6), lane = tid & 63, fr = lane & 15, fq = lane >> 4;
    const bf16_t* pq = (const bf16_t*)(ws_ + WS_PQ); const float* ab = (const float*)(ws_ + WS_AB);
    bf16_t* qn = (bf16_t*)(ws_ + WS_QN); bf16_t* kTg = (bf16_t*)(ws_ + WS_KT);
    float* gcg = (float*)(ws_ + WS_GC);
    const float* cw = p.dn_conv_w + (size_t)l * 3 * 1536;
    for (int item = bid_(); item < NCHUNK * 4; item += gdim_()) {
        const int g = item >> 2, h = item & 3, t0 = g * 64;
        if (tid < 128) { const int d = tid >> 6, i = tid & 63; const float a = ab[(size_t)(t0 + i) * 16 + d * 4 + h], bb = ab[(size_t)(t0 + i) * 16 + 8 + d * 4 + h];
            const float z = a + p.dn_dt_bias[l * 8 + d * 4 + h]; const float sp = fmaxf(z, 0.f) + log1pf(__expf(-fabsf(z)));
            float x = -__expf(p.dn_a_log[l * 8 + d * 4 + h]) * sp; betaS[d * 64 + i] = sigmf(bb);
#pragma unroll
            for (int off = 1; off < 64; off <<= 1) { const float up = lane_get(x, (i - off) & 63), dn = lane_get(x, (i + off) & 63);
                if (d == 0) { if (i >= off) x += up; } else { if (i + off < 64) x += dn; } }
            gcS[d * 64 + i] = x; gcg[((size_t)d * MT + t0 + i) * 4 + h] = x; }
        { const int i = tid >> 3, cg8 = tid & 7, t = t0 + i; const bool fst = seq_first(t), lst = seq_last(t);
#pragma unroll
          for (int part = 0; part < 3; ++part) {
              const int col = part * 512 + h * 128 + cg8 * 16; const bf16_t* r0 = pq + (size_t)t * 1536 + col;
              float x0[16], xm[16], xp[16], v[16];
              unpack8(*(const u32x4*)r0, x0); unpack8(*(const u32x4*)(r0 + 8), x0 + 8);
              if (!fst) { unpack8(*(const u32x4*)(r0 - 1536), xm); unpack8(*(const u32x4*)(r0 - 1536 + 8), xm + 8); }
              if (!lst) { unpack8(*(const u32x4*)(r0 + 1536), xp); unpack8(*(const u32x4*)(r0 + 1536 + 8), xp + 8); }
              float ss = 0.f;
#pragma unroll
              for (int e = 0; e < 16; ++e) { const float a = (fst ? 0.f : xm[e]) * cw[col + e] + x0[e] * cw[1536 + col + e] + (lst ? 0.f : xp[e]) * cw[3072 + col + e];
                  v[e] = siluf(a); ss += v[e] * v[e]; }
              if (part < 2) { ss += lane_get(ss, lane ^ 1); ss += lane_get(ss, lane ^ 2); ss += lane_get(ss, lane ^ 4);
                  const float rn = rsqrtf(ss + EPS) * (part == 0 ? 0.08838834764831845f : 1.f);
#pragma unroll
                  for (int e = 0; e < 16; ++e) v[e] *= rn; }
              if (part == 0) { const u32x4 w0 = pack8(v), w1 = pack8(v + 8);
                  *(u32x4*)(qS + i * 136 + cg8 * 16) = w0; *(u32x4*)(qS + i * 136 + cg8 * 16 + 8) = w1;
                  *(u32x4*)(qn + (size_t)t * 512 + h * 128 + cg8 * 16) = w0; *(u32x4*)(qn + (size_t)t * 512 + h * 128 + cg8 * 16 + 8) = w1; }
              else if (part == 1) { *(u32x4*)(kS + i * 136 + cg8 * 16) = pack8(v); *(u32x4*)(kS + i * 136 + cg8 * 16 + 8) = pack8(v + 8);
#pragma unroll
                  for (int e = 0; e < 16; ++e) kT[(cg8 * 16 + e) * 72 + i] = (bf16_t)f2bf(v[e]); }
              else {
#pragma unroll
                  for (int e = 0; e < 16; ++e) vT[(cg8 * 16 + e) * 72 + i] = (bf16_t)f2bf(v[e]); }
          } }
        __syncthreads();
        { const int j = tid >> 2, part = tid & 3; bf16_t* dst = kTg + ((size_t)(g * 4 + h) * 128 + j) * 64 + part * 16;
          *(u32x4*)dst = *(const u32x4*)(kT + j * 72 + part * 16); *(u32x4*)(dst + 8) = *(const u32x4*)(kT + j * 72 + part * 16 + 8); }
        { const int mt = wv & 3; const bf16_t* XS = (wv < 4) ? qS : kS; const int i = mt * 16 + fr;
          bf16x8 af[4];
#pragma unroll
          for (int ks = 0; ks < 4; ++ks) af[ks] = *(const bf16x8*)(XS + (mt * 16 + fr) * 136 + ks * 32 + fq * 8);
          const float gi0 = gcS[i], gi1 = gcS[64 + i], bi0 = betaS[i], bi1 = betaS[64 + i];
#pragma unroll
          for (int nt = 0; nt < 4; ++nt) { f32x4 acc = {0.f, 0.f, 0.f, 0.f};
#pragma unroll
              for (int ks = 0; ks < 4; ++ks) { const bf16x8 bfr = *(const bf16x8*)(kS + (nt * 16 + fr) * 136 + ks * 32 + fq * 8);
                  acc = __builtin_amdgcn_mfma_f32_16x16x32_bf16(bfr, af[ks], acc, 0, 0, 0); }
              const int jb = nt * 16 + fq * 4;
#pragma unroll
              for (int d = 0; d < 2; ++d) { float v[4];
#pragma unroll
                  for (int j = 0; j < 4; ++j) { const int jj = jb + j; const float e = __expf(fminf((d ? gi1 : gi0) - gcS[d * 64 + jj], 0.f));
                      if (wv < 4) { const bool ok = d == 0 ? (i >= jj) : (i <= jj); v[j] = ok ? acc[j] * e : 0.f; }
                      else { const bool ok = d == 0 ? (i > jj) : (i < jj); v[j] = ok ? (d ? bi1 : bi0) * acc[j] * e : 0.f; } }
                  if (wv < 4) { u32x2 w; w.x = pk2(v[0], v[1]); w.y = pk2(v[2], v[3]);
                      *(u32x2*)((bf16_t*)(ws_ + WS_AQK + d * SZAQK) + ((size_t)(g * 4 + h) * 64 + i) * 64 + jb) = w; }
                  else { const int md = d ? 63 : 0;
#pragma unroll
                      for (int j = 0; j < 4; ++j) Lm[d * 4096 + (i ^ md) * 64 + ((jb + j) ^ md)] = v[j]; } } } }
        __syncthreads();
        if (tid < 128) { const int d = tid >> 6, blk = (tid >> 4) & 3, col = tid & 15; const float* Lb = Lm + d * 4096 + (blk * 16) * 64 + blk * 16; float tc[16];
#pragma unroll
            for (int r = 0; r < 16; ++r) { float s = (r == col) ? 1.f : 0.f;
#pragma unroll
                for (int j = 0; j < r; ++j) s -= Lb[r * 64 + j] * tc[j];
                tc[r] = s; }
            float* Tb = Tm + d * 4096 + (blk * 16) * 64 + blk * 16 + col;
#pragma unroll
            for (int r = 0; r < 16; ++r) Tb[r * 64] = tc[r]; }
        __syncthreads();
#pragma unroll
        for (int dist = 1; dist <= 3; ++dist) {
            const int nper = 4 - dist; const bool act = wv < 2 * nper;
            const int d = wv / nper, R = dist + wv % nper, C = R - dist;
            const float* Ld = Lm + d * 4096; float* Td = Tm + d * 4096;
            if (act) { f32x4 X = {0.f, 0.f, 0.f, 0.f};
                for (int K = C; K < R; ++K) {
#pragma unroll
                    for (int kk = 0; kk < 4; ++kk) X = __builtin_amdgcn_mfma_f32_16x16x4f32(Ld[(R * 16 + fr) * 64 + K * 16 + kk * 4 + fq], Td[(K * 16 + kk * 4 + fq) * 64 + C * 16 + fr], X, 0, 0, 0); }
#pragma unroll
                for (int j = 0; j < 4; ++j) Xs[wv * 256 + (fq * 4 + j) * 16 + fr] = X[j]; }
            __syncthreads();
            if (act) { f32x4 Y = {0.f, 0.f, 0.f, 0.f};
#pragma unroll
                for (int kk = 0; kk < 4; ++kk) Y = __builtin_amdgcn_mfma_f32_16x16x4f32(Td[(R * 16 + fr) * 64 + R * 16 + kk * 4 + fq], Xs[wv * 256 + (kk * 4 + fq) * 16 + fr], Y, 0, 0, 0);
#pragma unroll
                for (int j = 0; j < 4; ++j) Td[(R * 16 + fq * 4 + j) * 64 + C * 16 + fr] = -Y[j]; }
            __syncthreads();
        }
        for (int idx = tid; idx < 8192; idx += 512) { const int d = idx >> 12, ip = (idx >> 6) & 63, cp = idx & 63, md = d ? 63 : 0, i = ip ^ md, c = cp ^ md;
            const float tv = ((cp >> 4) > (ip >> 4)) ? 0.f : Tm[d * 4096 + ip * 64 + cp]; const float bc = betaS[d * 64 + c];
            TS[(d * 2) * 4608 + i * 72 + c] = (bf16_t)f2bf(tv * bc); TS[(d * 2 + 1) * 4608 + i * 72 + c] = (bf16_t)f2bf(tv * bc * __expf(gcS[d * 64 + c])); }
        __syncthreads();
        { const int d = wv >> 2, which = (wv >> 1) & 1; const bf16_t* Tm2 = TS + (d * 2 + which) * 4608; const bf16_t* XT = which ? kT : vT;
          bf16_t* dst = (bf16_t*)(ws_ + (which ? WS_WB : WS_UB) + d * SZ512);
#pragma unroll
          for (int mi = 0; mi < 2; ++mi) { const int mt = (wv & 1) * 2 + mi;
              const bf16x8 a0 = *(const bf16x8*)(Tm2 + (mt * 16 + fr) * 72 + fq * 8), a1 = *(const bf16x8*)(Tm2 + (mt * 16 + fr) * 72 + 32 + fq * 8);
              bf16_t* drow = dst + (size_t)(t0 + mt * 16 + fr) * 512 + h * 128 + fq * 4;
#pragma unroll
              for (int nt = 0; nt < 8; ++nt) { f32x4 acc = {0.f, 0.f, 0.f, 0.f};
                  acc = __builtin_amdgcn_mfma_f32_16x16x32_bf16(*(const bf16x8*)(XT + (nt * 16 + fr) * 72 + fq * 8), a0, acc, 0, 0, 0);
                  acc = __builtin_amdgcn_mfma_f32_16x16x32_bf16(*(const bf16x8*)(XT + (nt * 16 + fr) * 72 + 32 + fq * 8), a1, acc, 0, 0, 0);
                  u32x2 w; w.x = pk2(acc[0], acc[1]); w.y = pk2(acc[2], acc[3]);
                  *(u32x2*)(drow + nt * 16) = w; } } }
        __syncthreads();
    }
}

namespace scn {
constexpr int ST_W = 0, ST_Q = 17408, ST_KT = 34816, ST_AQK = 53248, ST_U = 62464, ST_GC = 64512, ST_SIZE = 64768;
constexpr int OFF_ST = 2 * ST_SIZE, OFF_VN = OFF_ST + 4352, OFF_VS = OFF_VN + 2304;
struct Regs { u32x4 w0, w1, q0, q1, k0, k1, a, u; float g; };
struct Ptrs { const char *wb, *ub, *qn, *kTg, *aq, *gcg; bf16_t* ob; unsigned vo_w, vo_a, vo_k, vo_u, vo_g, lo_w, lo_a, lo_k, lo_u, lo_g; };
__device__ __forceinline__ void setup(Ptrs& P, int h, int sl, int tid) {
    { const int i = tid >> 3, pt = tid & 7; P.vo_w = (unsigned)((i * 512 + h * 128 + pt * 16) * 2); P.vo_a = (unsigned)(((h * 64 + i) * 64 + pt * 8) * 2);
      P.lo_w = (unsigned)((i * 136 + pt * 16) * 2); P.lo_a = (unsigned)(ST_AQK + (i * 72 + pt * 8) * 2); }
    { const int j = tid >> 2, pt = tid & 3; P.vo_k = (unsigned)(((h * 128 + j) * 64 + pt * 16) * 2); P.lo_k = (unsigned)(ST_KT + (j * 72 + pt * 16) * 2); }
    P.vo_u = (unsigned)((((tid >> 1) & 63) * 512 + h * 128 + sl * 16 + (tid & 1) * 8) * 2); P.lo_u = (unsigned)(ST_U + (((tid >> 1) & 63) * 16 + (tid & 1) * 8) * 2);
    P.vo_g = (unsigned)(((tid & 63) * 4 + h) * 4); P.lo_g = (unsigned)(ST_GC + (tid & 63) * 4);
}
__device__ __forceinline__ void load1(Regs& r, const Ptrs& P, int g) {
    const size_t o512 = (size_t)g * (64 * 512 * 2);
    const char* pw = P.wb + o512 + P.vo_w; const char* pq = P.qn + o512 + P.vo_w;
    r.w0 = *(const u32x4*)pw; r.w1 = *(const u32x4*)(pw + 16); r.q0 = *(const u32x4*)pq;
}
__device__ __forceinline__ void load2(Regs& r, const Ptrs& P, int g) {
    const size_t o512 = (size_t)g * (64 * 512 * 2), okt = (size_t)g * (4 * 128 * 64 * 2);
    r.q1 = *(const u32x4*)(P.qn + o512 + P.vo_w + 16);
    const char* pk = P.kTg + okt + P.vo_k; r.k0 = *(const u32x4*)pk; r.k1 = *(const u32x4*)(pk + 16);
}
__device__ __forceinline__ void load3(Regs& r, const Ptrs& P, int g) {
    const size_t o512 = (size_t)g * (64 * 512 * 2), oaq = (size_t)g * (4 * 64 * 64 * 2), ogc = (size_t)g * (64 * 4 * 4);
    r.a = *(const u32x4*)(P.aq + oaq + P.vo_a);
    r.u = *(const u32x4*)(P.ub + o512 + P.vo_u);
    r.g = *(const float*)(P.gcg + ogc + P.vo_g);
}
__device__ __forceinline__ void load(Regs& r, const Ptrs& P, int g, int tid) { load1(r, P, g); load2(r, P, g); load3(r, P, g); }
__device__ __forceinline__ void store(const Regs& r, const Ptrs& P, unsigned char* b, int tid) {
    *(u32x4*)(b + ST_W + P.lo_w) = r.w0; *(u32x4*)(b + ST_W + P.lo_w + 16) = r.w1;
    *(u32x4*)(b + ST_Q + P.lo_w) = r.q0; *(u32x4*)(b + ST_Q + P.lo_w + 16) = r.q1;
    *(u32x4*)(b + P.lo_a) = r.a;
    *(u32x4*)(b + P.lo_k) = r.k0; *(u32x4*)(b + P.lo_k + 16) = r.k1;
    if (tid < 128) *(u32x4*)(b + P.lo_u) = r.u;
    if (tid < 64) *(float*)(b + P.lo_g) = r.g;
}
__device__ __forceinline__ void step(unsigned char* sm, const unsigned char* bs, f32x4& accS, const Ptrs& P, int g, int h, int sl, int d, int wv, int fr, int fq, Regs& rl, int gld) {
    bf16_t* StS = (bf16_t*)(sm + OFF_ST); bf16_t* vnT = (bf16_t*)(sm + OFF_VN); bf16_t* vsT = (bf16_t*)(sm + OFF_VS);
    const bf16_t* wS = (const bf16_t*)(bs + ST_W); const bf16_t* qS = (const bf16_t*)(bs + ST_Q); const bf16_t* kTS = (const bf16_t*)(bs + ST_KT);
    const bf16_t* aS = (const bf16_t*)(bs + ST_AQK); const bf16_t* uS = (const bf16_t*)(bs + ST_U); const float* gcS = (const float*)(bs + ST_GC);
    const int t0 = g * 64, mt = wv & 3;
    const float gl = gcS[d ? 0 : 63];
    load1(rl, P, gld);
    f32x4 acc1 = {0.f, 0.f, 0.f, 0.f};
    if (wv < 4) {
#pragma unroll
        for (int ks = 0; ks < 4; ++ks) acc1 = __builtin_amdgcn_mfma_f32_16x16x32_bf16(*(const bf16x8*)(wS + (mt * 16 + fr) * 136 + ks * 32 + fq * 8),
                                                                                       *(const bf16x8*)(StS + fr * 136 + ks * 32 + fq * 8), acc1, 0, 0, 0);
        float vn[4], vs[4];
#pragma unroll
        for (int j = 0; j < 4; ++j) { const int i = mt * 16 + fq * 4 + j; vn[j] = bf2f(uS[i * 16 + fr]) - acc1[j]; vs[j] = vn[j] * __expf(gl - gcS[i]); }
        u32x2 w1, w2; w1.x = pk2(vn[0], vn[1]); w1.y = pk2(vn[2], vn[3]); w2.x = pk2(vs[0], vs[1]); w2.y = pk2(vs[2], vs[3]);
        *(u32x2*)(vnT + fr * 72 + mt * 16 + fq * 4) = w1; *(u32x2*)(vsT + fr * 72 + mt * 16 + fq * 4) = w2;
    } else {
#pragma unroll
        for (int ks = 0; ks < 4; ++ks) acc1 = __builtin_amdgcn_mfma_f32_16x16x32_bf16(*(const bf16x8*)(StS + fr * 136 + ks * 32 + fq * 8),
                                                                                       *(const bf16x8*)(qS + (mt * 16 + fr) * 136 + ks * 32 + fq * 8), acc1, 0, 0, 0);
    }
    bf16x8 ka[2], aa[2];
#pragma unroll
    for (int ks = 0; ks < 2; ++ks) { ka[ks] = *(const bf16x8*)(kTS + (wv * 16 + fr) * 72 + ks * 32 + fq * 8); aa[ks] = *(const bf16x8*)(aS + (mt * 16 + fr) * 72 + ks * 32 + fq * 8); }
    const float egi = __expf(gcS[mt * 16 + fr]), egl = __expf(gl);
    __syncthreads();
    load2(rl, P, gld);
    if (wv >= 4) { f32x4 acc3 = {0.f, 0.f, 0.f, 0.f};
#pragma unroll
        for (int ks = 0; ks < 2; ++ks) acc3 = __builtin_amdgcn_mfma_f32_16x16x32_bf16(*(const bf16x8*)(vnT + fr * 72 + ks * 32 + fq * 8), aa[ks], acc3, 0, 0, 0);
        const int i = mt * 16 + fr;
        u32x2 w; w.x = pk2(egi * acc1[0] + acc3[0], egi * acc1[1] + acc3[1]); w.y = pk2(egi * acc1[2] + acc3[2], egi * acc1[3] + acc3[3]);
        *(u32x2*)(P.ob + (size_t)(t0 + i) * 512 + h * 128 + sl * 16 + fq * 4) = w; }
    { f32x4 accn = {0.f, 0.f, 0.f, 0.f};
#pragma unroll
      for (int ks = 0; ks < 2; ++ks) accn = __builtin_amdgcn_mfma_f32_16x16x32_bf16(ka[ks], *(const bf16x8*)(vsT + fr * 72 + ks * 32 + fq * 8), accn, 0, 0, 0);
#pragma unroll
      for (int j = 0; j < 4; ++j) accS[j] = accS[j] * egl + accn[j];
      u32x2 w; w.x = pk2(accS[0], accS[1]); w.y = pk2(accS[2], accS[3]);
      *(u32x2*)(StS + fr * 136 + wv * 16 + fq * 4) = w; }
    load3(rl, P, gld);
}
}

__device__ void scan_phase(const Params& p, unsigned char* ws_, unsigned char* sm, int wvs_) {
    using namespace scn;
    const int tid = opaque_tid(wvs_), wv = __builtin_amdgcn_readfirstlane(tid >> 6), lane = tid & 63, fr = lane & 15, fq = lane >> 4;
    sm += (tid >> 10);
    bf16_t* StS = (bf16_t*)(sm + OFF_ST);
    for (int wu = bid_(); wu < 256; wu += gdim_()) {
        const int xcd = wu & 7, idx = wu >> 3, chain = xcd * 4 + (idx >> 3), sl = idx & 7, b = chain >> 3, h = (chain >> 1) & 3, d = chain & 1;
        Ptrs P; P.wb = (const char*)(ws_ + WS_WB + d * SZ512); P.ub = (const char*)(ws_ + WS_UB + d * SZ512);
        P.qn = (const char*)(ws_ + WS_QN); P.kTg = (const char*)(ws_ + WS_KT);
        P.aq = (const char*)(ws_ + WS_AQK + d * SZAQK); P.gcg = (const char*)(ws_ + WS_GC) + (size_t)d * MT * 16;
        P.ob = (bf16_t*)(ws_ + WS_PQ + d * SZ512); setup(P, h, sl, tid);
        f32x4 accS = {0.f, 0.f, 0.f, 0.f};
        for (int i = tid; i < 16 * 136; i += 512) StS[i] = 0;
#define SCAN_CHUNK(n_) ((n_) < 4 ? 512 + b * 4 + (d ? 3 - (n_) : (n_)) : b * 128 + (d ? 127 - ((n_) - 4) : ((n_) - 4)))
        Regs rA, rB; rA.u = (u32x4){0u, 0u, 0u, 0u}; rB.u = rA.u; rA.g = 0.f; rB.g = 0.f;
        { const int g0 = SCAN_CHUNK(0); load(rA, P, g0, tid); store(rA, P, sm, tid); }
        { const int g1 = SCAN_CHUNK(1); load(rA, P, g1, tid); const int g2 = SCAN_CHUNK(2); load(rB, P, g2, tid); }
        __syncthreads();
        for (int n = 0; n < 132; n += 2) {
            store(rA, P, sm + ST_SIZE, tid);
            { const int g = SCAN_CHUNK(n); const int nn = min(n + 3, 131); const int gn = SCAN_CHUNK(nn); step(sm, sm, accS, P, g, h, sl, d, wv, fr, fq, rA, gn); }
            __syncthreads();
            store(rB, P, sm, tid);
            { const int g = SCAN_CHUNK(n + 1); const int nn = min(n + 4, 131); const int gn = SCAN_CHUNK(nn); step(sm, sm + ST_SIZE, accS, P, g, h, sl, d, wv, fr, fq, rB, gn); }
            __syncthreads();
        }
#undef SCAN_CHUNK
    }
}

__device__ void ofinal_phase(const Params& p, unsigned char* ws_, int l, int nrows, int wvs_) {
    const int tid = opaque_tid(wvs_);
    const bf16_t* o0 = (const bf16_t*)(ws_ + WS_PQ); const bf16_t* o1 = (const bf16_t*)(ws_ + WS_PQ + SZ512); bf16_t* bout = (bf16_t*)(ws_ + WS_BOUT);
    const float* g = p.dn_norm_g + l * 128;
    for (int base = bid_() * 8; base < nrows; base += gdim_() * 8) {
        const int tok = base + (tid >> 6), h = (tid >> 4) & 3, part = tid & 15, col = h * 128 + part * 8;
        float a[8], b[8], z[8];
        unpack8(*(const u32x4*)(o0 + (size_t)tok * 512 + col), a); unpack8(*(const u32x4*)(o1 + (size_t)tok * 512 + col), b);
        unpack8(*(const u32x4*)(bout + (size_t)tok * 1024 + col), z);
        float ss = 0.f;
#pragma unroll
        for (int e = 0; e < 8; ++e) { a[e] += b[e]; ss += a[e] * a[e]; }
        { const int ln = tid & 63; ss += lane_get(ss, ln ^ 1); ss += lane_get(ss, ln ^ 2); ss += lane_get(ss, ln ^ 4); ss += lane_get(ss, ln ^ 8); }
        const float rn = rsqrtf(ss * (1.f / 128.f) + EPS);
#pragma unroll
        for (int e = 0; e < 8; ++e) a[e] = a[e] * rn * g[part * 8 + e] * z[e];
        *(u32x4*)(bout + (size_t)tok * 1024 + col) = pack8(a);
    }
}

__device__ void final_phase(const Params& p, const bf16_t* xb, float* out_, int wvs_) {
    const int tid = opaque_tid(wvs_), wave = tid >> 6, lane = tid & 63;
    const int rstride = gdim_() * 8;
    for (int row0 = bid_() * 8 + wave; row0 < ML; row0 += 3 * rstride) {
        f32x4 vv[3][4];
#pragma unroll
        for (int k = 0; k < 3; ++k) { const int row = min(row0 + k * rstride, ML - 1);
#pragma unroll
            for (int j = 0; j < 4; ++j) { const u32x2 w2 = *(const u32x2*)(xb + (size_t)row * 1024 + j * 256 + lane * 4); vv[k][j] = (f32x4){bflo(w2.x), bfhi(w2.x), bflo(w2.y), bfhi(w2.y)}; } }
#pragma unroll
        for (int k = 0; k < 3; ++k) { const int row = row0 + k * rstride; if (row < ML) {
            float* xr = out_ + (size_t)row * 1024; float ss = 0.f;
#pragma unroll
            for (int j = 0; j < 4; ++j) ss += vv[k][j][0] * vv[k][j][0] + vv[k][j][1] * vv[k][j][1] + vv[k][j][2] * vv[k][j][2] + vv[k][j][3] * vv[k][j][3];
#pragma unroll
            for (int o = 32; o >= 1; o >>= 1) ss += lane_get(ss, lane ^ o);
            const float rstd = rsqrtf(ss * (1.f / 1024.f) + EPS);
#pragma unroll
            for (int j = 0; j < 4; ++j) { const int col = j * 256 + lane * 4; const f32x4 gg = *(const f32x4*)(p.final_norm_g + col);
                f32x4 y; y[0] = vv[k][j][0] * rstd * gg[0]; y[1] = vv[k][j][1] * rstd * gg[1]; y[2] = vv[k][j][2] * rstd * gg[2]; y[3] = vv[k][j][3] * rstd * gg[3];
                __builtin_nontemporal_store(y, (f32x4*)(xr + col)); } } }
    }
}

#define XB_TMO      128
#define XB_XCNT(j)  (256  + 64 * (j))
#define XB_XSUB(j)  (1280 + 64 * (j))
#define XB_XGEN(j)  (2304 + 64 * (j))
#define XB_TOP      3328
#define XB_TOPGEN   3392
#define XCD_BAR_WORDS 3456
#define XB_SPIN_CAP (1u << 20)
__device__ __forceinline__ unsigned xb_ld(unsigned* p)              { return __hip_atomic_load(p, __ATOMIC_RELAXED, __HIP_MEMORY_SCOPE_AGENT); }
__device__ __forceinline__ unsigned xb_add(unsigned* p, unsigned v) { return __hip_atomic_fetch_add(p, v, __ATOMIC_RELAXED, __HIP_MEMORY_SCOPE_AGENT); }
__device__ __forceinline__ unsigned xb_xcc_id() { return (unsigned)__builtin_amdgcn_s_getreg((3 << 11) | 20) & 0xFu; }
#define XB_SPIN(cond, bar) do { unsigned _sp = 0; while (cond) { \
    if ((++_sp & 255u) == 0u) { if (xb_ld(&(bar)[XB_TMO])) break; if (_sp > XB_SPIN_CAP) { atomicAdd(&(bar)[XB_TMO], 1u); break; } } } } while (0)
struct XcdBarrier { unsigned* bar; unsigned x; volatile LAS unsigned* st; };
__device__ __forceinline__ XcdBarrier xcd_barrier_post(unsigned* bar, volatile LAS unsigned* st) {
    XcdBarrier b; b.bar = bar; b.x = xb_xcc_id(); b.st = st;
    if (threadIdx.x == 0) (void)xb_add(&bar[XB_XCNT(b.x)], 1u);
    return b;
}
__device__ __forceinline__ void xcd_barrier_complete(unsigned* bar, unsigned x, unsigned& nloc, unsigned& nx) {
    const unsigned G = gridDim.x * gridDim.y * gridDim.z;
    unsigned sum, cnt, mine, sp = 0u;
    for (;;) {
        sum = 0u; cnt = 0u; mine = 0u;
#pragma unroll
        for (unsigned j = 0; j < 16; ++j) { const unsigned c = xb_ld(&bar[XB_XCNT(j)]); sum += c; cnt += (c > 0u) ? 1u : 0u; mine = (j == x) ? c : mine; }
        if (sum == G) break;
        __builtin_amdgcn_s_sleep(1);
        if ((++sp & 255u) == 0u) { if (xb_ld(&bar[XB_TMO])) break; if (sp > XB_SPIN_CAP) { atomicAdd(&bar[XB_TMO], 1u); break; } }
    }
    nloc = mine > 0u ? mine : 1u; nx = cnt > 0u ? cnt : 1u;
}
__device__ __forceinline__ void xcd_barrier(const XcdBarrier& b) {
    asm volatile("s_waitcnt vmcnt(0)" ::: "memory");
    __syncthreads();
    if (threadIdx.x == 0) {
        unsigned* bar = b.bar;
        __builtin_amdgcn_s_waitcnt(0);
        unsigned nloc = b.st[0], nx = b.st[1];
        if (nloc == 0u) { xcd_barrier_complete(bar, b.x, nloc, nx); b.st[0] = nloc; b.st[1] = nx; }
        const unsigned old = xb_add(&bar[XB_XSUB(b.x)], 1u);
        const unsigned gen = old / nloc;
        if (old + 1u == (gen + 1u) * nloc) {
            __builtin_amdgcn_fence(__ATOMIC_RELEASE, "agent");
            asm volatile("s_waitcnt vmcnt(0)" ::: "memory");
            const unsigned og = xb_add(&bar[XB_TOP], 1u);
            const unsigned tg = og / nx;
            if (og + 1u == (tg + 1u) * nx) xb_add(&bar[XB_TOPGEN], 1u);
            else XB_SPIN(xb_ld(&bar[XB_TOPGEN]) == tg, bar);
            __builtin_amdgcn_fence(__ATOMIC_ACQUIRE, "agent");
            xb_add(&bar[XB_XGEN(b.x)], 1u);
            asm volatile("s_waitcnt vmcnt(0)" ::: "memory");
        } else {
            XB_SPIN(xb_ld(&bar[XB_XGEN(b.x)]) == gen, bar);
            __builtin_amdgcn_fence(__ATOMIC_ACQUIRE, "agent");
            asm volatile("s_waitcnt vmcnt(0)" ::: "memory");
        }
    }
    __syncthreads();
}

#ifndef PROBE_MASK
#define PROBE_MASK 0u
#endif
#ifndef PH_MASK
#define PH_MASK 0xFFFF
#endif
constexpr int N_PHASES = 26;
__global__ void __launch_bounds__(512, 2) fwd_megakernel(Params pin) {
    extern __shared__ __attribute__((aligned(16))) unsigned char lds[];
    cg::grid_group grid = cg::this_grid();
    LAS unsigned char* ldsl = (LAS unsigned char*)lds;
    const int G = gridDim.x;
    const int wvs_ = __builtin_amdgcn_readfirstlane(threadIdx.x >> 6);
    const Params& p0 = pin;
    volatile LAS unsigned* bst = (volatile LAS unsigned*)(ldsl + (LDS_BYTES - 64));
    if (threadIdx.x < 2) bst[threadIdx.x] = 0u;
    __syncthreads();
    const XcdBarrier xbar = xcd_barrier_post((unsigned*)(pin.ws + WS_BAR), bst);
    for (int phi = p0.ph_lo; phi < p0.ph_hi; ++phi) {
        int ph = __builtin_amdgcn_readfirstlane(phi); asm volatile("" : "+s"(ph));
        int bx = blockIdx.x; asm volatile("" : "+s"(bx));
        const Params& p = p0;
        size_t zoff_ = 0; asm volatile("" : "+s"(zoff_));
        unsigned char* ws_ = p0.ws + zoff_;
        float* out_ = p0.out + zoff_;
        float* ctxres = (float*)(ws_ + WS_CTX);
        const float* mod = (const float*)(ws_ + WS_MOD);
        bf16_t* hb = (bf16_t*)(ws_ + WS_H);
        bf16_t* side = (bf16_t*)((unsigned char*)out_ + 64 * MiB);
        unsigned long long pt0 = 0; if (PROBE_MASK) pt0 = __builtin_amdgcn_s_memrealtime();
        if (ph == 0) { if (PH_MASK & 0x1000) { mod_phase(p, ws_, lds, wvs_); __syncthreads(); cvt_phase(p, ws_, 0, lds, wvs_); } }
        else if (ph == 25) { if (PH_MASK & 0x2000) final_phase(p, (const bf16_t*)(ws_ + WS_H), out_, wvs_); }
        else {
            const int l = (ph - 1) / 12, sp = (ph - 1) % 12;
            const int Mrows = (l == 0) ? MT : ML;
            const float* xl = (l == 0) ? p.x : out_; const float* xc = (l == 0) ? p.ctx : ctxres;
            switch ((PH_MASK >> sp) & 1 ? sp : 99) {
            case 99: break;
            case 0: if (l == 1) cvt_phase(p, ws_, 1, lds, wvs_); modulate_phase(p, ws_, l, 1, p.x, l == 0 ? nullptr : (const bf16_t*)out_, l == 0 ? (bf16_t*)out_ : nullptr, xc, MT, nullptr, l == 1 ? (const float*)(ws_ + WS_BOUT) : nullptr, 11, mod + (size_t)4 * 6144 + 5120, wvs_); break;
            case 1: { pg8::Gemm g{hb, (const bf16_t*)(ws_ + WS_WIN1), 1024, 1024, 1024, nullptr, nullptr, 0}; pg8::StaticOrder S; S.init(MT, 3328, G, bx);
                pg8::EpiP2 E{(bf16_t*)(ws_ + WS_PQ), side, (float*)(ws_ + WS_AB), (bf16_t*)(ws_ + WS_BOUT)};
                pg8::gemm_phase<pg8::EpiP2, pg8::StaticOrder>(ldsl, g, S, E, wvs_); break; }
            case 2: break;
            case 3: prep_phase(p, ws_, l, lds, wvs_); __syncthreads(); branch_phase(p, ws_, side, l, Mrows, lds, wvs_); break;
            case 4: scan_phase(p, ws_, lds, wvs_); break;
            case 5: ofinal_phase(p, ws_, l, Mrows, wvs_); break;
            case 6: break;
            case 7: { { pg8::Gemm g{(const bf16_t*)(ws_ + WS_BOUT), (const bf16_t*)(ws_ + WS_WBR), 1024, 1024, 512, hb, (const bf16_t*)(ws_ + WS_WG), 1024};
                  pg8::StaticOrder S; S.init(ML, 1024, G, bx); S.fused = 1;
                  pg8::EpiYG E{(bf16_t*)(ws_ + WS_R) + (size_t)bx * 65536, (bf16_t*)(ws_ + WS_PQ)};
                  pg8::gemm_phase<pg8::EpiYG, pg8::StaticOrder, true>(ldsl, g, S, E, wvs_); }
                if (l == 0) {
                  pg8::Gemm g{(const bf16_t*)(ws_ + WS_BOUT), (const bf16_t*)(ws_ + WS_WBR), 1024, 1024, 512, hb, (const bf16_t*)(ws_ + WS_WG), 1024}; pg8::CtxPairOrder S{G, (bx + 64) % G};
                  pg8::EpiYZ E{(bf16_t*)(ws_ + WS_R)};
                  pg8::gemm_phase<pg8::EpiYZ, pg8::CtxPairOrder, true>(ldsl, g, S, E, wvs_); }
                break; }
            case 8: { { pg8::Gemm g{(const bf16_t*)(ws_ + WS_PQ), (const bf16_t*)(ws_ + WS_WO3), 1024, 1024, 1024, nullptr, nullptr, 0}; pg8::StaticOrder S; S.init(ML, 1024, G, bx);
                  pg8::EpiRes E{(const bf16_t*)out_, (bf16_t*)out_, mod + (size_t)l * 5 * 6144 + 2048};
                  pg8::gemm_phase<pg8::EpiRes, pg8::StaticOrder>(ldsl, g, S, E, wvs_); }
                if (l == 0) {
                  pg8::Gemm g{(const bf16_t*)(ws_ + WS_R), (const bf16_t*)(ws_ + WS_WO3), 3072, 1024, 256, nullptr, nullptr, 0}; pg8::CtxOrder<4, 12, 4> S{G, (bx + 32) % G, 512, 512, 1 << 30, 0, 0, 0};
                  pg8::EpiPart E{(float*)(ws_ + WS_BOUT), 12};
                  pg8::gemm_phase<pg8::EpiPart, pg8::CtxOrder<4, 12, 4>>(ldsl, g, S, E, wvs_); }
                break; }
            case 9: modulate_phase(p, ws_, l, 2, p.x, (const bf16_t*)out_, nullptr, l == 0 ? p.ctx : ctxres, Mrows, l == 0 ? ctxres : nullptr, l == 0 ? (const float*)(ws_ + WS_BOUT) : nullptr, 12, mod + (size_t)4 * 6144 + 2048, wvs_); break;
            case 10: { pg8::Gemm g{hb, (const bf16_t*)(ws_ + WS_WGU), 1024, 1024, 1024, nullptr, nullptr, 0}; pg8::StaticOrder S; S.init(Mrows, 2 * DFF, G, bx);
                pg8::EpiSwi E{(bf16_t*)(ws_ + WS_R)};
                pg8::gemm_phase<pg8::EpiSwi, pg8::StaticOrder>(ldsl, g, S, E, wvs_); break; }
            case 11: { { pg8::Gemm g{(const bf16_t*)(ws_ + WS_R), (const bf16_t*)(ws_ + WS_WDN), DFF, DFF, DFF, nullptr, nullptr, 0}; pg8::StaticOrder S; S.init(ML, 1024, G, bx);
                  pg8::EpiRes E{(const bf16_t*)out_, l == 0 ? (bf16_t*)out_ : hb, mod + (size_t)l * 5 * 6144 + 5120};
                  pg8::gemm_phase<pg8::EpiRes, pg8::StaticOrder>(ldsl, g, S, E, wvs_); }
                if (l == 0) {
                  pg8::Gemm g{(const bf16_t*)(ws_ + WS_R), (const bf16_t*)(ws_ + WS_WDN), DFF, DFF, 256, nullptr, nullptr, 0}; pg8::CtxOrder<4, 11, 0> S{G, (bx + 48) % G, 512, 512, 1 << 30, 0, 0, 0};
                  pg8::EpiPart E{(float*)(ws_ + WS_BOUT), 11};
                  pg8::gemm_phase<pg8::EpiPart, pg8::CtxOrder<4, 11, 0>>(ldsl, g, S, E, wvs_); }
                break; }
            }
        }
        if (PROBE_MASK) { if ((PROBE_MASK >> ph) & 1u) { __syncthreads(); const unsigned long long pt1 = __builtin_amdgcn_s_memrealtime(); const unsigned long long tend = pt1 + (pt1 - pt0);
            while (__builtin_amdgcn_s_memrealtime() < tend) __builtin_amdgcn_s_sleep(4); } }
        if (phi + 1 < p0.ph_hi && ph != 19 && ph != 7 && ph != 3 && ph != 15) { if (phi == p0.ph_lo) grid.sync(); else { XcdBarrier xb2 = xbar; xb2.bar = (unsigned*)(ws_ + WS_BAR); xcd_barrier(xb2); } }
    }
}

extern "C" void kernel_launch(void* const* d_in, const int* in_sizes, int n_in, void* d_out, int out_size, void* d_ws, size_t ws_size, hipStream_t stream) {
    static int grid_blocks = 0;
    if (grid_blocks == 0) {
        if (n_in != 23 || out_size != ML * DM || ws_size < WS_END) { fprintf(stderr, "kernel_launch: unexpected shapes (n_in %d out %d ws %zu)\n", n_in, out_size, ws_size); grid_blocks = -1; return; }
        int dev = 0, cus = 0, per_cu = 0;
        hipGetDevice(&dev);
        hipDeviceGetAttribute(&cus, hipDeviceAttributeMultiprocessorCount, dev);
        if (hipFuncSetAttribute((const void*)fwd_megakernel, hipFuncAttributeMaxDynamicSharedMemorySize, LDS_BYTES) != hipSuccess) { fprintf(stderr, "kernel_launch: hipFuncSetAttribute failed\n"); grid_blocks = -1; return; }
        hipOccupancyMaxActiveBlocksPerMultiprocessor(&per_cu, (const void*)fwd_megakernel, 512, LDS_BYTES);
        if (per_cu < 1) { fprintf(stderr, "kernel_launch: occupancy query says %d blocks/CU\n", per_cu); grid_blocks = -1; return; }
        grid_blocks = cus * (per_cu > 1 ? 1 : per_cu);
    }
    if (grid_blocks < 0) return;
    Params p{};
    const float** pp = (const float**)&p;
    for (int i = 0; i < 23; ++i) pp[i] = (const float*)d_in[i];
    p.out = (float*)d_out; p.ws = (unsigned char*)d_ws; p.ph_lo = 0; p.ph_hi = N_PHASES;
    if (hipMemsetAsync((char*)d_ws + WS_BAR, 0, XCD_BAR_WORDS * 4, stream) != hipSuccess) { fprintf(stderr, "memset failed\n"); return; }
    void* args[] = {&p};
    hipError_t e = hipLaunchCooperativeKernel((const void*)fwd_megakernel, dim3(grid_blocks), dim3(512), args, LDS_BYTES, stream);
    if (e != hipSuccess) fprintf(stderr, "cooperative launch failed: %s (grid %d)\n", hipGetErrorString(e), grid_blocks);
}
```
